# Optimizing an MI355X kernel written in HIP

```python
import jax, jax.numpy as jnp
from jax import lax
import numpy as np

D_MODEL = 1024
BATCH = 4
SEQ = 8192
DEPTH = 4
DEC_BATCH = 8
DEC_SEQ = 2048
PAST_LEN = 128

HEAD_DIM = 64
GRID_W = 64
A_HEADS = 8
A_KV_HEADS = 2
B_HEADS = 4
B_KV_HEADS = 2
C_HEADS = 4
Q_BLOCK = 128
WINDOW = 128
CHUNK = 128
ROPE_THETA = 10000.0
MEM_LEN = 256
X_HEADS = 4
X_HEAD_DIM = D_MODEL // X_HEADS
D_FF = ((8 * D_MODEL // 3 + 255) // 256) * 256
EPS = 1e-6
A_Q = A_HEADS * HEAD_DIM
A_KV = A_KV_HEADS * HEAD_DIM
B_Q = B_HEADS * HEAD_DIM
B_KV = B_KV_HEADS * HEAD_DIM
C_W = C_HEADS * HEAD_DIM
MIX_W = A_Q + B_Q + C_W
IN_SPLITS = (A_Q, A_KV, A_KV, B_Q, B_KV, B_KV, C_W, C_W, C_W, C_W)
IN_W = A_Q + 2 * A_KV + B_Q + 2 * B_KV + 4 * C_W
NEG_INF = -1e30

kernel_name = 'hybrid_bidir_parallel_heads_encoder'


def rmsnorm(x, g):
    xf = x.astype(jnp.float32)
    y = xf * lax.rsqrt(jnp.mean(xf * xf, axis=-1, keepdims=True) + EPS)
    return (y * g.astype(jnp.float32)).astype(x.dtype)


def rope_freqs(pos, dim):
    inv = ROPE_THETA ** (-jnp.arange(0, dim, 2, dtype=jnp.float32) / dim)
    return pos.astype(jnp.float32)[:, None] * inv[None, :]


def apply_rope(x, ang):
    half = x.shape[-1] // 2
    cos = jnp.cos(ang)[None, :, None, :]
    sin = jnp.sin(ang)[None, :, None, :]
    xf = x.astype(jnp.float32)
    x1, x2 = xf[..., :half], xf[..., half:]
    return jnp.concatenate([x1 * cos - x2 * sin, x1 * sin + x2 * cos], axis=-1).astype(x.dtype)


def axial_attention(q, k, v, g_q, g_k, ang):
    bsz, T, H, d = q.shape
    G = H // A_KV_HEADS
    q = apply_rope(rmsnorm(q, g_q), ang)
    k = apply_rope(rmsnorm(k, g_k), ang)
    scale = d ** -0.5
    qb = q.reshape(bsz, T // Q_BLOCK, Q_BLOCK, A_KV_HEADS, G, d).transpose(1, 0, 2, 3, 4, 5)

    def one_block(qi):
        s = jnp.einsum('bqkgd,bskd->bkgqs', qi, k, preferred_element_type=jnp.float32) * scale
        p = jax.nn.softmax(s, axis=-1).astype(v.dtype)
        return jnp.einsum('bkgqs,bskd->bqkgd', p, v)

    o = lax.map(one_block, qb)
    return o.transpose(1, 0, 2, 3, 4, 5).reshape(bsz, T, H * d)


def window_attention(q, k, v, sink, ang):
    bsz, T, H, d = q.shape
    K = B_KV_HEADS
    G = H // K
    W = WINDOW
    nb = T // W
    q = apply_rope(q, ang)
    k = apply_rope(k, ang)
    pad = ((0, 0), (W, W), (0, 0), (0, 0))
    kp = jnp.pad(k, pad).reshape(bsz, nb + 2, W, K, d)
    vp = jnp.pad(v, pad).reshape(bsz, nb + 2, W, K, d)
    kw = jnp.concatenate([kp[:, :-2], kp[:, 1:-1], kp[:, 2:]], axis=2)
    vw = jnp.concatenate([vp[:, :-2], vp[:, 1:-1], vp[:, 2:]], axis=2)
    qb = q.reshape(bsz, nb, W, K, G, d)
    s = jnp.einsum('bnqkgd,bnskd->bnkgqs', qb, kw, preferred_element_type=jnp.float32) * d ** -0.5
    blk = jnp.arange(nb)[:, None]
    qpos = blk * W + jnp.arange(W)[None, :]
    kpos = (blk - 1) * W + jnp.arange(3 * W)[None, :]
    rel = kpos[:, None, :] - qpos[:, :, None]
    valid = (jnp.abs(rel) <= W) & (kpos[:, None, :] >= 0) & (kpos[:, None, :] < T)
    s = jnp.where(valid[None, :, None, None], s, NEG_INF)
    sink_col = jnp.broadcast_to(sink.astype(jnp.float32).reshape(1, 1, K, G, 1, 1), s.shape[:-1] + (1,))
    p = jax.nn.softmax(jnp.concatenate([s, sink_col], axis=-1), axis=-1)[..., :-1].astype(v.dtype)
    o = jnp.einsum('bnkgqs,bnskd->bnqkgd', p, vw)
    return o.reshape(bsz, T, H * d)


def bidir_retention(q, k, v, gate, p_dec_f, p_dec_b, g_gn, ang):
    bsz, T, H, d = q.shape
    C = CHUNK
    nc = T // C
    f32 = jnp.float32
    qc = apply_rope(q, ang).astype(f32).reshape(bsz, nc, C, H, d)
    kc = (apply_rope(k, ang).astype(f32) * d ** -0.5).reshape(bsz, nc, C, H, d)
    vc = v.astype(f32).reshape(bsz, nc, C, H, d)
    lgf = -jnp.exp(p_dec_f.astype(f32))
    lgb = -jnp.exp(p_dec_b.astype(f32))
    idx = jnp.arange(C, dtype=f32)
    diff = idx[:, None] - idx[None, :]
    mask = jnp.where(diff >= 0,
                     jnp.exp(lgf[:, None, None] * jnp.maximum(diff, 0.0)),
                     jnp.exp(lgb[:, None, None] * jnp.maximum(-diff, 0.0)))
    s = jnp.einsum('bnahd,bnchd->bnhac', qc, kc) * mask
    o = jnp.einsum('bnhac,bnchd->bnahd', s, vc)
    zero = jnp.zeros((bsz, H, d, d), f32)
    kv_f = jnp.einsum('bnchd,hc,bnche->nbhde', kc, jnp.exp(lgf[:, None] * (C - 1 - idx)[None, :]), vc)
    dec_f = jnp.exp(lgf * C)[None, :, None, None]
    _, s_prev = lax.scan(lambda S, kv: (dec_f * S + kv, S), zero, kv_f)
    o = o + jnp.einsum('bnahd,ha,nbhde->bnahe', qc, jnp.exp(lgf[:, None] * (idx + 1.0)[None, :]), s_prev)
    kv_b = jnp.einsum('bnchd,hc,bnche->nbhde', kc, jnp.exp(lgb[:, None] * idx[None, :]), vc)
    dec_b = jnp.exp(lgb * C)[None, :, None, None]
    _, r_next = lax.scan(lambda R, kv: (dec_b * R + kv, R), zero, kv_b, reverse=True)
    o = o + jnp.einsum('bnahd,ha,nbhde->bnahe', qc, jnp.exp(lgb[:, None] * (C - idx)[None, :]), r_next)
    o = o.reshape(bsz, T, H, d)
    oc = o - jnp.mean(o, axis=-1, keepdims=True)
    o = oc * lax.rsqrt(jnp.mean(oc * oc, axis=-1, keepdims=True) + EPS)
    o = o.reshape(bsz, T, H * d) * g_gn.astype(f32)
    return (o * jax.nn.silu(gate.astype(f32))).astype(gate.dtype)


def memory_cross_attention(h, m, w_q, w_k, w_v, w_o):
    bsz, T, _ = h.shape
    q = (h @ w_q).reshape(bsz, T, X_HEADS, X_HEAD_DIM)
    k = (m @ w_k).reshape(bsz, -1, X_HEADS, X_HEAD_DIM)
    v = (m @ w_v).reshape(bsz, -1, X_HEADS, X_HEAD_DIM)
    s = jnp.einsum('bthd,bmhd->bhtm', q, k, preferred_element_type=jnp.float32) * X_HEAD_DIM ** -0.5
    p = jax.nn.softmax(s, axis=-1).astype(v.dtype)
    o = jnp.einsum('bhtm,bmhd->bthd', p, v).reshape(bsz, T, D_MODEL)
    return o @ w_o


def encoder_trunk(x, mem, g_mix, w_in, a_q_norm, a_k_norm, a_out_norm, b_sink, b_out_norm,
                  c_decay_fwd, c_decay_bwd, c_gn, w_out, g_cross, g_mem, w_xq, w_xk, w_xv, w_xo,
                  g_ffn, w_gate, w_up, w_down, g_final):
    bsz, T, _ = x.shape
    rows = T // GRID_W
    row = jnp.repeat(jnp.arange(rows), GRID_W)
    col = jnp.tile(jnp.arange(GRID_W), rows)
    ang_axial = jnp.concatenate([rope_freqs(row, HEAD_DIM // 2), rope_freqs(col, HEAD_DIM // 2)], axis=-1)
    ang_seq = rope_freqs(jnp.arange(T), HEAD_DIM)
    cuts = [int(c) for c in np.cumsum(IN_SPLITS)[:-1]]

    def heads(t):
        return t.reshape(bsz, T, -1, HEAD_DIM)

    for l in range(DEPTH):
        h = rmsnorm(x, g_mix[l])
        qa, ka, va, qb, kb, vb, qc, kc, vc, gc = jnp.split(h @ w_in[l], cuts, axis=-1)
        oa = rmsnorm(axial_attention(heads(qa), heads(ka), heads(va), a_q_norm[l], a_k_norm[l], ang_axial),
                     a_out_norm[l])
        ob = rmsnorm(window_attention(heads(qb), heads(kb), heads(vb), b_sink[l], ang_seq), b_out_norm[l])
        oc = bidir_retention(heads(qc), heads(kc), heads(vc), gc, c_decay_fwd[l], c_decay_bwd[l], c_gn[l], ang_seq)
        x = x + jnp.concatenate([oa, ob, oc], axis=-1) @ w_out[l]
        x = x + memory_cross_attention(rmsnorm(x, g_cross[l]), rmsnorm(mem, g_mem[l]),
                                       w_xq[l], w_xk[l], w_xv[l], w_xo[l])
        h = rmsnorm(x, g_ffn[l])
        x = x + (jax.nn.silu(h @ w_gate[l]) * (h @ w_up[l])) @ w_down[l]
    return rmsnorm(x, g_final)


def setup_inputs(seed: int = 0) -> dict:
    key = jax.random.key(seed)
    ks = iter(jax.random.split(key, 32))

    def nrm(shape, scale):
        return scale * jax.random.normal(next(ks), shape, jnp.float32)

    def gain(shape):
        return 1.0 + 0.05 * jax.random.normal(next(ks), shape, jnp.float32)

    base = jnp.asarray(np.log(-np.log(1.0 - 2.0 ** (-5.0 - np.arange(C_HEADS)))).astype(np.float32))
    L = DEPTH
    return {
        'x_prompt': nrm((BATCH, SEQ, D_MODEL), 1.0),
        'x_sample': nrm((DEC_BATCH, DEC_SEQ, D_MODEL), 1.0),
        'mem_prompt': nrm((BATCH, MEM_LEN, D_MODEL), 1.0),
        'mem_sample': nrm((DEC_BATCH, MEM_LEN, D_MODEL), 1.0),
        'g_mix': gain((L, D_MODEL)),
        'w_in': nrm((L, D_MODEL, IN_W), D_MODEL ** -0.5),
        'a_q_norm': gain((L, HEAD_DIM)),
        'a_k_norm': gain((L, HEAD_DIM)),
        'a_out_norm': gain((L, A_Q)),
        'b_sink': nrm((L, B_HEADS), 0.5),
        'b_out_norm': gain((L, B_Q)),
        'c_decay_fwd': base[None, :] + nrm((L, C_HEADS), 0.05),
        'c_decay_bwd': base[None, :] + nrm((L, C_HEADS), 0.05),
        'c_gn': gain((L, C_W)),
        'w_out': nrm((L, MIX_W, D_MODEL), MIX_W ** -0.5),
        'g_cross': gain((L, D_MODEL)),
        'g_mem': gain((L, D_MODEL)),
        'w_xq': nrm((L, D_MODEL, D_MODEL), D_MODEL ** -0.5),
        'w_xk': nrm((L, D_MODEL, D_MODEL), D_MODEL ** -0.5),
        'w_xv': nrm((L, D_MODEL, D_MODEL), D_MODEL ** -0.5),
        'w_xo': nrm((L, D_MODEL, D_MODEL), D_MODEL ** -0.5),
        'g_ffn': gain((L, D_MODEL)),
        'w_gate': nrm((L, D_MODEL, D_FF), D_MODEL ** -0.5),
        'w_up': nrm((L, D_MODEL, D_FF), D_MODEL ** -0.5),
        'w_down': nrm((L, D_FF, D_MODEL), D_FF ** -0.5),
        'g_final': gain((D_MODEL,)),
    }


def reference(x_prompt, x_sample, mem_prompt, mem_sample, g_mix, w_in, a_q_norm, a_k_norm, a_out_norm,
              b_sink, b_out_norm, c_decay_fwd, c_decay_bwd, c_gn, w_out, g_cross, g_mem, w_xq, w_xk,
              w_xv, w_xo, g_ffn, w_gate, w_up, w_down, g_final):
    y_prompt = encoder_trunk(x_prompt, mem_prompt, g_mix, w_in, a_q_norm, a_k_norm, a_out_norm, b_sink,
                             b_out_norm, c_decay_fwd, c_decay_bwd, c_gn, w_out, g_cross, g_mem, w_xq,
                             w_xk, w_xv, w_xo, g_ffn, w_gate, w_up, w_down, g_final)
    y_sample = encoder_trunk(x_sample, mem_sample, g_mix, w_in, a_q_norm, a_k_norm, a_out_norm, b_sink,
                             b_out_norm, c_decay_fwd, c_decay_bwd, c_gn, w_out, g_cross, g_mem, w_xq,
                             w_xk, w_xv, w_xo, g_ffn, w_gate, w_up, w_down, g_final)
    return (y_prompt, y_sample)
```

```cpp
#include <hip/hip_runtime.h>
#include <hip/hip_cooperative_groups.h>
#include <stdint.h>
#include <stdio.h>
namespace cg = cooperative_groups;

#define NT 256
#define DI __device__ __forceinline__
typedef unsigned short u16;
typedef short bf16x8 __attribute__((ext_vector_type(8)));
typedef float f32x16 __attribute__((ext_vector_type(16)));
typedef __bf16 bf16x2_t __attribute__((ext_vector_type(2)));
typedef float f32x2_t __attribute__((ext_vector_type(2)));
typedef _Float16 h16x2 __attribute__((ext_vector_type(2)));
typedef unsigned u32x16 __attribute__((ext_vector_type(16)));
typedef unsigned u32x8 __attribute__((ext_vector_type(8)));
#define LD4(vec, i, ptr) do { const uint4 t_ = *(const uint4*)(ptr); vec[4 * (i)] = t_.x; vec[4 * (i) + 1] = t_.y; vec[4 * (i) + 2] = t_.z; vec[4 * (i) + 3] = t_.w; } while (0)
#define GET4(vec, i) make_uint4(vec[4 * (i)], vec[4 * (i) + 1], vec[4 * (i) + 2], vec[4 * (i) + 3])
#define GETLO(vec, i) make_uint2(vec[4 * (i)], vec[4 * (i) + 1])
#define GETHI(vec, i) make_uint2(vec[4 * (i) + 2], vec[4 * (i) + 3])

constexpr int M_TOK = 49152, MP = 32768, DM = 1024, DFF = 2816, NMEM = 3072, HALF_M = 24576;
constexpr int PROJ_W = 1792;
constexpr int C_QA = 0, C_KA = 512, C_QB = 640, C_KB = 896, C_QC = 1024, C_KC = 1280, C_GC = 1536;
constexpr float EPS = 1e-6f;
constexpr float LOG2E = 1.4426950408889634f;
constexpr size_t MiB = 1048576;
constexpr size_t OFF_CTRL = 0, OFF_SSQ = 65536, OFF_TAB = 4 * MiB, OFF_MEMB = 8 * MiB, OFF_MEMK = 14 * MiB, OFF_MEMVT = 20 * MiB,
                 OFF_ST = 26 * MiB, OFF_W = 50 * MiB, OFF_REGA = 174 * MiB, OFF_MIXB = 402 * MiB, OFF_SSQ2 = 498 * MiB, WS_NEED = 504 * MiB;
constexpr size_t W_LAYER = 16252928, W_IN = 0, W_OUT = 2359296, W_XQ = 3407872, W_XKV = 4456448, W_XO = 6553600, W_GU = 7602176, W_DN = 13369344;
constexpr int LDS_BYTES = 73728;

struct Params {
  const float *x_prompt, *x_sample, *mem_prompt, *mem_sample, *g_mix, *w_in, *a_q_norm, *a_k_norm, *a_out_norm, *b_sink, *b_out_norm,
      *c_decay_fwd, *c_decay_bwd, *c_gn, *w_out, *g_cross, *g_mem, *w_xq, *w_xk, *w_xv, *w_xo, *g_ffn, *w_gate, *w_up, *w_down, *g_final;
  float* out; char* ws;
};

struct EpiArgs {
  const float* ssq_in; u16* proj; u16* vt; const h16x2* tab_seq; const h16x2* tab_ax; const float* qn; const float* kn;
  float* x; u16* xb; float* ssq_out; u16* o16; u16* o16b; int row_off; u16* memk; u16* memvt;
};

DI unsigned pk2(float a, float b) { f32x2_t v = {a, b}; bf16x2_t r = __builtin_convertvector(v, bf16x2_t); return __builtin_bit_cast(unsigned, r); }
DI float bflo(unsigned u) { return __uint_as_float(u << 16); }
DI float bfhi(unsigned u) { return __uint_as_float(u & 0xffff0000u); }
DI int crow(int i, int h) { return (i & 3) + 8 * (i >> 2) + 4 * h; }
DI float ex2(float x) { return __builtin_amdgcn_exp2f(x); }
DI float max3f(float a, float b, float c) { float d; asm("v_max3_f32 %0, %1, %2, %3" : "=v"(d) : "v"(a), "v"(b), "v"(c)); return d; }
DI float max3f_after_mfma(float a, float b, float c) { float d; asm volatile("s_nop 11\n\tv_max3_f32 %0, %1, %2, %3" : "=v"(d) : "v"(a), "v"(b), "v"(c)); return d; }
DI f32x16 mfma(bf16x8 a, bf16x8 b, f32x16 c) { return __builtin_amdgcn_mfma_f32_32x32x16_bf16(a, b, c, 0, 0, 0); }
DI f32x16 zero16() { f32x16 z; for (int i = 0; i < 16; ++i) z[i] = 0.f; return z; }
DI bf16x8 mk8(unsigned a, unsigned b, unsigned c, unsigned d) { uint4 u = make_uint4(a, b, c, d); return __builtin_bit_cast(bf16x8, u); }
DI bf16x8 cat8(uint2 lo, uint2 hi) { uint4 u = make_uint4(lo.x, lo.y, hi.x, hi.y); return __builtin_bit_cast(bf16x8, u); }

DI void grid_bar(unsigned* ctrl, unsigned& gen) {
  asm volatile("s_waitcnt vmcnt(0) lgkmcnt(0)" ::: "memory");
  __syncthreads();
  if (threadIdx.x == 0) {
    gen += 1;
    const unsigned g = blockIdx.x & 7, ng = gridDim.x >> 3;
    __builtin_amdgcn_fence(__ATOMIC_RELEASE, "agent");
    asm volatile("s_waitcnt vmcnt(0)" ::: "memory");
    const unsigned old = atomicAdd(ctrl + 16 + 16 * g, 1u);
    if (old == gen * ng - 1) {
      const unsigned o2 = atomicAdd(ctrl, 1u);
      if (o2 == gen * 8 - 1) {
#pragma unroll
        for (int i = 0; i < 8; ++i) __hip_atomic_store(ctrl + 144 + 16 * i, gen, __ATOMIC_RELAXED, __HIP_MEMORY_SCOPE_AGENT);
      }
    }
    while (__hip_atomic_load(ctrl + 144 + 16 * g, __ATOMIC_RELAXED, __HIP_MEMORY_SCOPE_AGENT) < gen) __builtin_amdgcn_s_sleep(1);
    __builtin_amdgcn_fence(__ATOMIC_ACQUIRE, "agent");
    asm volatile("s_waitcnt vmcnt(0)" ::: "memory");
  }
  __syncthreads();
}
DI int next_tile(unsigned* ctr, int* s_tile) {
  __syncthreads();
  if (threadIdx.x == 0) *s_tile = (int)atomicAdd(ctr, 1u);
  __syncthreads();
  return *s_tile;
}
template <class NF, class TF>
DI void run_queues(unsigned* ctr8, int* s_tile, NF nfun, TF tfun) {
  const int x0 = blockIdx.x & 7, ng = gridDim.x >> 3, rank = blockIdx.x >> 3;
  for (int s = 0; s < 8; ++s) {
    const int x = (x0 + s) & 7, n = nfun(x);
    if (n == 0) continue;
    int t = s == 0 ? rank : next_tile(ctr8 + x, s_tile) + ng;
    while (t < n) {
      int nx = 0;
      if (threadIdx.x == 0) nx = (int)atomicAdd(ctr8 + x, 1u) + ng;
      tfun(x, t);
      __syncthreads();
      if (threadIdx.x == 0) *s_tile = nx;
      __syncthreads();
      t = *s_tile;
    }
  }
}
template <class TF>
DI void run_pairs(int npt, TF tfun) {
  const int x = blockIdx.x & 7, rank = blockIdx.x >> 3, hp = gridDim.x >> 4;
  const int pj = rank >> 1, member = rank & 1;
  for (int pt = pj; pt < npt; pt += hp) { __syncthreads(); tfun(x, pt, member); }
  __syncthreads();
}
DI int tok_pos(int m) { return m < MP ? (m & 8191) : (m & 2047); }

template <int EPI>
DI void epilogue_rows(char* lds, int m0, int n0, const EpiArgs& ea) {
  int tid_ = threadIdx.x; asm volatile("" : "+v"(tid_)); const int tid = tid_;
  float* T = (float*)lds;
  float* RS = T + 128 * 132;
  if (EPI != 2) { if (tid < 128) { const float4 s0 = *(const float4*)(ea.ssq_in + (size_t)(m0 + tid) * 8), s1 = *(const float4*)(ea.ssq_in + (size_t)(m0 + tid) * 8 + 4);
      RS[tid] = rsqrtf((((s0.x + s0.y) + (s0.z + s0.w)) + ((s1.x + s1.y) + (s1.z + s1.w))) * (1.f / 1024.f) + EPS); } }
  __syncthreads();
  if (EPI == 1) {
    const int nt = n0 >> 7;
    if (nt < 14) {
      const bool is_a = nt < 5, is_g = nt >= 12, is_q = (nt < 4) || (nt == 5) || (nt == 6);
      const float* gain = nt < 4 ? ea.qn : ea.kn;
      const h16x2* tab = is_a ? ea.tab_ax : ea.tab_seq;
      const float osc = is_q ? 0.125f * LOG2E : ((nt == 10 || nt == 11) ? 0.125f : 1.0f);
#pragma unroll 2
      for (int it = 0; it < 8; ++it) {
        const int idx = it * 256 + tid, row = idx >> 4, c8 = idx & 15, hd = c8 >> 3, i0 = (c8 & 7) * 8;
        const float rs = RS[row];
        float v[8], o[8];
        const float* tp = T + row * 132 + c8 * 8;
#pragma unroll
        for (int j = 0; j < 8; ++j) v[j] = tp[j] * rs;
        if (is_g) {
#pragma unroll
          for (int j = 0; j < 8; ++j) o[j] = v[j] * __builtin_amdgcn_rcpf(1.f + ex2(-v[j] * LOG2E));
        } else {
          float pv[8];
          const float* pp = T + row * 132 + hd * 64 + (i0 ^ 32);
#pragma unroll
          for (int j = 0; j < 8; ++j) pv[j] = pp[j] * rs;
          if (is_a) {
            float ss = 0.f;
#pragma unroll
            for (int j = 0; j < 8; ++j) ss += v[j] * v[j];
            ss += __shfl_xor(ss, 1); ss += __shfl_xor(ss, 2); ss += __shfl_xor(ss, 4);
            const float nr = rsqrtf(ss * (1.f / 64.f) + EPS);
#pragma unroll
            for (int j = 0; j < 8; ++j) { v[j] *= nr * gain[i0 + j]; pv[j] *= nr * gain[(i0 ^ 32) + j]; }
          }
          const int t = tok_pos(m0 + row);
          const h16x2* cs = tab + t * 32 + (i0 & 31);
          const bool lo = i0 < 32;
#pragma unroll
          for (int j = 0; j < 8; ++j) { const h16x2 ch = cs[j]; const float cx = (float)ch.x, cy = (float)ch.y; o[j] = (lo ? (v[j] * cx - pv[j] * cy) : (pv[j] * cy + v[j] * cx)) * osc; }
        }
        uint4 w = make_uint4(pk2(o[0], o[1]), pk2(o[2], o[3]), pk2(o[4], o[5]), pk2(o[6], o[7]));
        *(uint4*)(ea.proj + (size_t)(m0 + row) * PROJ_W + nt * 128 + c8 * 8) = w;
      }
    } else {
      const int vrow0 = (nt - 14) * 128;
#pragma unroll 4
      for (int it = 0; it < 8; ++it) {
        const int idx = it * 256 + tid, n = idx & 127, r0 = (idx >> 7) * 8;
        float o[8];
#pragma unroll
        for (int j = 0; j < 8; ++j) o[j] = T[(r0 + j) * 132 + n] * RS[r0 + j];
        uint4 w = make_uint4(pk2(o[0], o[1]), pk2(o[2], o[3]), pk2(o[4], o[5]), pk2(o[6], o[7]));
        *(uint4*)(ea.vt + (size_t)(vrow0 + n) * M_TOK + m0 + r0) = w;
      }
    }
  } else if (EPI == 2) {
#pragma unroll
    for (int it = 0; it < 8; ++it) {
      const int idx = it * 256 + tid, row = idx >> 4, c8 = idx & 15;
      const float* tp = T + row * 132 + c8 * 8;
      u16* xp = ea.xb + (size_t)(m0 + row) * DM + n0 + c8 * 8;
      const uint4 u = *(const uint4*)xp;
      const float v0 = bflo(u.x) + tp[0], v1 = bfhi(u.x) + tp[1], v2 = bflo(u.y) + tp[2], v3 = bfhi(u.y) + tp[3],
                  v4 = bflo(u.z) + tp[4], v5 = bfhi(u.z) + tp[5], v6 = bflo(u.w) + tp[6], v7 = bfhi(u.w) + tp[7];
      *(uint4*)xp = make_uint4(pk2(v0, v1), pk2(v2, v3), pk2(v4, v5), pk2(v6, v7));
      float ss = v0 * v0 + v1 * v1 + v2 * v2 + v3 * v3 + v4 * v4 + v5 * v5 + v6 * v6 + v7 * v7;
      ss += __shfl_xor(ss, 1); ss += __shfl_xor(ss, 2); ss += __shfl_xor(ss, 4); ss += __shfl_xor(ss, 8);
      if (c8 == 0) ea.ssq_out[(size_t)(m0 + row) * 8 + (n0 >> 7)] = ss;
    }
  } else if (EPI == 3) {
#pragma unroll
    for (int it = 0; it < 8; ++it) {
      const int idx = it * 256 + tid, row = idx >> 4, c8 = idx & 15;
      const float rs = RS[row] * (0.0625f * LOG2E);
      const float* tp = T + row * 132 + c8 * 8;
      uint4 w = make_uint4(pk2(tp[0] * rs, tp[1] * rs), pk2(tp[2] * rs, tp[3] * rs), pk2(tp[4] * rs, tp[5] * rs), pk2(tp[6] * rs, tp[7] * rs));
      *(uint4*)(ea.o16 + (size_t)(m0 + row) * DM + n0 + c8 * 8) = w;
    }
  } else if (EPI == 4) {
    const int nt = n0 >> 7;
#pragma unroll
    for (int it = 0; it < 4; ++it) {
      const int idx = it * 256 + tid, row = idx >> 3, c8 = idx & 7;
      const float rs = RS[row];
      const float* tp = T + row * 132 + c8 * 8;
      float o[8];
#pragma unroll
      for (int j = 0; j < 8; ++j) { const float g = tp[j] * rs, u = tp[64 + j] * rs; o[j] = g * __builtin_amdgcn_rcpf(1.f + ex2(-g * LOG2E)) * u; }
      uint4 w = make_uint4(pk2(o[0], o[1]), pk2(o[2], o[3]), pk2(o[4], o[5]), pk2(o[6], o[7]));
      if (nt < 38) *(uint4*)(ea.o16 + (size_t)(m0 + row) * 2432 + nt * 64 + c8 * 8) = w;
      else *(uint4*)(ea.o16b + (size_t)(m0 + row) * 384 + (nt - 38) * 64 + c8 * 8) = w;
    }
  } else if (EPI == 5) {
    const int nt = n0 >> 7;
    if (nt < 8) {
      for (int it = 0; it < 8; ++it) {
        const int idx = it * 256 + tid, row = idx >> 4, c8 = idx & 15;
        const float rs = RS[row];
        const float* tp = T + row * 132 + c8 * 8;
        uint4 w = make_uint4(pk2(tp[0] * rs, tp[1] * rs), pk2(tp[2] * rs, tp[3] * rs), pk2(tp[4] * rs, tp[5] * rs), pk2(tp[6] * rs, tp[7] * rs));
        *(uint4*)(ea.memk + (size_t)(m0 + row) * DM + n0 + c8 * 8) = w;
      }
    } else {
      const int bm = m0 >> 8, j0 = m0 & 255;
      for (int it = 0; it < 8; ++it) {
        const int idx = it * 256 + tid, n = idx & 127, r0 = (idx >> 7) * 8;
        float o[8];
#pragma unroll
        for (int j = 0; j < 8; ++j) o[j] = T[(r0 + j) * 132 + n] * RS[r0 + j];
        uint4 w = make_uint4(pk2(o[0], o[1]), pk2(o[2], o[3]), pk2(o[4], o[5]), pk2(o[6], o[7]));
        *(uint4*)(ea.memvt + ((size_t)(bm * 1024 + (nt - 8) * 128 + n)) * 256 + j0 + r0) = w;
      }
    }
  }
}


template <int EPI>
DI void gemm_tile(const u16* __restrict__ At, int lda, const u16* __restrict__ Bt, int ldb, int K, int m0, int n0, char* lds, const EpiArgs& ea,
                  const u16* __restrict__ At2, int lda2, int ksplit) {
  int tid_ = threadIdx.x; asm volatile("" : "+v"(tid_)); const int tid = tid_, lane = tid & 63, wid = tid >> 6, r = lane & 31, h = lane >> 5;
  const int wr = wid >> 1, wc = wid & 1;
  f32x16 acc[2][2];
  acc[0][0] = zero16(); acc[0][1] = zero16(); acc[1][0] = zero16(); acc[1][1] = zero16();
  const int srow = tid >> 3, skc = tid & 7;
  const u16* ga = At + (size_t)srow * lda + skc * 8;
  const u16* ga2 = At2 + (size_t)srow * lda2 + skc * 8;
  const int ks = ksplit * 64;
  const u16* gb = Bt + (size_t)srow * ldb + skc * 8;
  const int soff = srow * 144 + skc * 16;
  u32x16 ra0, rb0, ra1, rb1;
#define G_LOAD(RA, RB, KO) { const int ko_ = (KO); const u16* gx_ = ko_ < ks ? ga + ko_ : ga2 + (ko_ - ks); const int ldx_ = ko_ < ks ? lda : lda2; \
    _Pragma("unroll") for (int i = 0; i < 4; ++i) { LD4(RA, i, gx_ + (size_t)(32 * i) * ldx_); LD4(RB, i, gb + (size_t)(32 * i) * ldb + ko_); } }
#define G_STORE(RA, RB, ST) _Pragma("unroll") for (int i = 0; i < 4; ++i) { *(uint4*)(lds + (ST) * 36864 + soff + i * 4608) = GET4(RA, i); *(uint4*)(lds + (ST) * 36864 + 18432 + soff + i * 4608) = GET4(RB, i); }
#define G_COMPUTE(ST) _Pragma("unroll") for (int s = 0; s < 4; ++s) { \
      const char* base = lds + (ST) * 36864; \
      bf16x8 a0 = *(const bf16x8*)(base + aoff + s * 32), a1 = *(const bf16x8*)(base + aoff + 4608 + s * 32); \
      bf16x8 b0 = *(const bf16x8*)(base + boff + s * 32), b1 = *(const bf16x8*)(base + boff + 4608 + s * 32); \
      acc[0][0] = mfma(a0, b0, acc[0][0]); acc[0][1] = mfma(a0, b1, acc[0][1]); \
      acc[1][0] = mfma(a1, b0, acc[1][0]); acc[1][1] = mfma(a1, b1, acc[1][1]); }
#define G_SCHED { __builtin_amdgcn_sched_group_barrier(0x100, 4, 0); \
    __builtin_amdgcn_sched_group_barrier(0x100, 4, 0); __builtin_amdgcn_sched_group_barrier(0x020, 2, 0); __builtin_amdgcn_sched_group_barrier(0x008, 4, 0); __builtin_amdgcn_sched_group_barrier(0x200, 2, 0); \
    __builtin_amdgcn_sched_group_barrier(0x100, 4, 0); __builtin_amdgcn_sched_group_barrier(0x020, 2, 0); __builtin_amdgcn_sched_group_barrier(0x008, 4, 0); __builtin_amdgcn_sched_group_barrier(0x200, 2, 0); \
    __builtin_amdgcn_sched_group_barrier(0x100, 4, 0); __builtin_amdgcn_sched_group_barrier(0x020, 2, 0); __builtin_amdgcn_sched_group_barrier(0x008, 4, 0); __builtin_amdgcn_sched_group_barrier(0x200, 2, 0); \
    __builtin_amdgcn_sched_group_barrier(0x020, 2, 0); __builtin_amdgcn_sched_group_barrier(0x008, 4, 0); __builtin_amdgcn_sched_group_barrier(0x200, 2, 0); }
  const int nk = K >> 6;
  const int aoff = (wr * 64 + r) * 144 + h * 16;
  const int boff = 18432 + (wc * 64 + r) * 144 + h * 16;
  G_LOAD(ra0, rb0, 0)
  G_LOAD(ra1, rb1, 64)
  G_STORE(ra0, rb0, 0)
  __syncthreads();
  for (int kt = 0; kt < nk; kt += 2) {
    { const int ko = (kt + 2 < nk ? kt + 2 : nk - 2) * 64; G_LOAD(ra0, rb0, ko) }
    G_COMPUTE(0)
    G_STORE(ra1, rb1, 1)
    G_SCHED
    __syncthreads();
    { const int ko = (kt + 3 < nk ? kt + 3 : nk - 1) * 64; G_LOAD(ra1, rb1, ko) }
    G_COMPUTE(1)
    G_STORE(ra0, rb0, 0)
    G_SCHED
    __syncthreads();
  }
#undef G_LOAD
#undef G_STORE
#undef G_COMPUTE
#undef G_SCHED
  {
    float* T = (float*)lds;
#pragma unroll
    for (int mt = 0; mt < 2; ++mt)
#pragma unroll
      for (int nt = 0; nt < 2; ++nt)
#pragma unroll
        for (int i = 0; i < 16; ++i) T[(wr * 64 + mt * 32 + crow(i, h)) * 132 + wc * 64 + nt * 32 + r] = acc[mt][nt][i];
  }
  epilogue_rows<EPI>(lds, m0, n0, ea);
}

template <int EPI>
DI void gemm_tile256(const u16* __restrict__ At, int lda, const u16* __restrict__ Bt, int ldb, int K, int m0, int n0, char* lds, const EpiArgs& ea) {
  int tid_ = threadIdx.x; asm volatile("" : "+v"(tid_)); const int tid = tid_, lane = tid & 63, wid = tid >> 6, r = lane & 31, h = lane >> 5;
  const int wr = wid >> 1, wc = wid & 1;
  f32x16 acc[4][2];
#pragma unroll
  for (int i = 0; i < 4; ++i) { acc[i][0] = zero16(); acc[i][1] = zero16(); }
  const int srow = tid >> 3, skc = tid & 7;
  const u16* ga = At + (size_t)srow * lda + skc * 8;
  const u16* gb = Bt + (size_t)srow * ldb + skc * 8;
  const int soff = srow * 144 + skc * 16;
  const int aoff = (wr * 128 + r) * 144 + h * 16;
  const int boff = 36864 + (wc * 64 + r) * 144 + h * 16;
  u32x16 raL, raH, rb;
#define H_LOAD(KO) _Pragma("unroll") for (int i = 0; i < 4; ++i) { LD4(raL, i, ga + (size_t)(32 * i) * lda + (KO)); LD4(raH, i, ga + (size_t)(128 + 32 * i) * lda + (KO)); LD4(rb, i, gb + (size_t)(32 * i) * ldb + (KO)); }
  const int nk = K >> 6;
  H_LOAD(0)
  for (int kt = 0; kt < nk; ++kt) {
    __syncthreads();
#pragma unroll
    for (int i = 0; i < 4; ++i) { *(uint4*)(lds + soff + i * 4608) = GET4(raL, i); *(uint4*)(lds + 18432 + soff + i * 4608) = GET4(raH, i); *(uint4*)(lds + 36864 + soff + i * 4608) = GET4(rb, i); }
    __syncthreads();
    if (kt + 1 < nk) { H_LOAD((kt + 1) * 64) }
#pragma unroll
    for (int s = 0; s < 4; ++s) {
      bf16x8 b0 = *(const bf16x8*)(lds + boff + s * 32), b1 = *(const bf16x8*)(lds + boff + 4608 + s * 32);
#pragma unroll
      for (int mt = 0; mt < 4; ++mt) {
        bf16x8 a = *(const bf16x8*)(lds + aoff + mt * 4608 + s * 32);
        acc[mt][0] = mfma(a, b0, acc[mt][0]); acc[mt][1] = mfma(a, b1, acc[mt][1]);
      }
    }
  }
#undef H_LOAD
#pragma unroll
  for (int p = 0; p < 2; ++p) {
    __syncthreads();
    if (wr == p) {
      float* T = (float*)lds;
#pragma unroll
      for (int mt = 0; mt < 4; ++mt)
#pragma unroll
        for (int nt = 0; nt < 2; ++nt)
#pragma unroll
          for (int i = 0; i < 16; ++i) T[(mt * 32 + crow(i, h)) * 132 + wc * 64 + nt * 32 + r] = acc[mt][nt][i];
    }
    epilogue_rows<EPI>(lds, m0 + p * 128, n0, ea);
  }
}

template <bool WIN, bool NOMAX = false>
DI void attn64_tile(const u16* __restrict__ proj, const u16* __restrict__ vt, u16* __restrict__ mix, int brow0, int T, int q0, int qcol,
                    int kcol, int vtrow, int outcol, float sink2, char* lds) {
  int tid_ = threadIdx.x; asm volatile("" : "+v"(tid_)); const int tid = tid_, lane = tid & 63, wid = tid >> 6, r = lane & 31, h = lane >> 5;
  const int qi = q0 + wid * 32 + r;
  bf16x8 qf[4];
  {
    const u16* qp = proj + (size_t)(brow0 + qi) * PROJ_W + qcol + h * 8;
#pragma unroll
    for (int s = 0; s < 4; ++s) qf[s] = *(const bf16x8*)(qp + s * 16);
  }
  int kt_lo = 0, kt_hi = T >> 6;
  if (WIN) { kt_lo = (q0 - 128) >> 6; if (kt_lo < 0) kt_lo = 0; kt_hi = (q0 + 256) >> 6; if (kt_hi > (T >> 6)) kt_hi = T >> 6; }
  const int srow = tid >> 3, skc = tid & 7;
  const u16* gk = proj + (size_t)(brow0 + srow) * PROJ_W + kcol + skc * 8;
  const u16* gv = vt + (size_t)(vtrow + srow) * M_TOK + brow0 + skc * 8;
  u32x8 rk0, rv0, rk1, rv1;
#define A_LOAD(RK, RV, KT) { const int k0_ = (KT) * 64; _Pragma("unroll") for (int i = 0; i < 2; ++i) { LD4(RK, i, gk + (size_t)(k0_ + 32 * i) * PROJ_W); LD4(RV, i, gv + (size_t)(32 * i) * M_TOK + k0_); } }
#define A_STORE(RK, RV, ST) { _Pragma("unroll") for (int i = 0; i < 2; ++i) { *(uint4*)(lds + (ST) * 17920 + skoff + i * 4608) = GET4(RK, i); \
    *(uint2*)(lds + (ST) * 17920 + svoff + i * 4352) = GETLO(RV, i); *(uint2*)(lds + (ST) * 17920 + svoff + i * 4352 + 8) = GETHI(RV, i); } }
  const int skoff = srow * 144 + skc * 16, svoff = 9216 + srow * 136 + skc * 16;
  const int ntile = kt_hi - kt_lo;
  A_LOAD(rk0, rv0, kt_lo)
  A_LOAD(rk1, rv1, kt_lo + 1)
  A_STORE(rk0, rv0, 0)
  __syncthreads();
  f32x16 O0 = zero16(), O1 = zero16();
  float m = WIN ? sink2 : 0.f, l = 0.f;
  const int koff = r * 144 + h * 16, voff = 9216 + r * 136 + h * 8;
  auto compute = [&](const char* base, int kt) {
    f32x16 s0, s1;
    if (NOMAX) { s0 = zero16(); s1 = zero16(); }
    else { const float nm = -m;
#pragma unroll
      for (int i = 0; i < 16; ++i) { s0[i] = nm; s1[i] = nm; } }
#pragma unroll
    for (int s = 0; s < 4; ++s) {
      bf16x8 k0f = *(const bf16x8*)(base + koff + s * 32), k1f = *(const bf16x8*)(base + koff + 4608 + s * 32);
      s0 = mfma(k0f, qf[s], s0); s1 = mfma(k1f, qf[s], s1);
    }
    if (WIN) {
      const int kb = kt * 64;
#pragma unroll
      for (int i = 0; i < 16; ++i) {
        const int j0 = kb + crow(i, h), d0 = qi - j0, d1 = d0 - 32;
        if (d0 > 128 || d0 < -128) s0[i] = -1e30f;
        if (d1 > 128 || d1 < -128) s1[i] = -1e30f;
      }
    }
    if (!NOMAX) {
    float mx = max3f_after_mfma(s0[0], s1[0], s0[1]);
    mx = max3f(mx, s1[1], s0[2]);
#pragma unroll
    for (int i = 2; i < 15; ++i) mx = max3f(mx, s1[i], s0[i + 1]);
    mx = max3f(mx, s1[15], s1[15]);
    mx = fmaxf(mx, __shfl_xor(mx, 32));
    if (__any(mx > 8.f)) {
      const float dm = mx > 8.f ? mx : 0.f, alpha = ex2(-dm);
      m += dm; l *= alpha;
#pragma unroll
      for (int i = 0; i < 16; ++i) { s0[i] -= dm; s1[i] -= dm; O0[i] *= alpha; O1[i] *= alpha; }
    }
    }
    f32x2_t ps2 = {0.f, 0.f};
#pragma unroll
    for (int i = 0; i < 16; i += 2) {
      s0[i] = ex2(s0[i]); s0[i + 1] = ex2(s0[i + 1]); s1[i] = ex2(s1[i]); s1[i + 1] = ex2(s1[i + 1]);
      ps2 += (f32x2_t){s0[i], s0[i + 1]}; ps2 += (f32x2_t){s1[i], s1[i + 1]};
    }
    l += ps2.x + ps2.y;
    bf16x8 pf[2][2];
    pf[0][0] = mk8(pk2(s0[0], s0[1]), pk2(s0[2], s0[3]), pk2(s0[4], s0[5]), pk2(s0[6], s0[7]));
    pf[0][1] = mk8(pk2(s0[8], s0[9]), pk2(s0[10], s0[11]), pk2(s0[12], s0[13]), pk2(s0[14], s0[15]));
    pf[1][0] = mk8(pk2(s1[0], s1[1]), pk2(s1[2], s1[3]), pk2(s1[4], s1[5]), pk2(s1[6], s1[7]));
    pf[1][1] = mk8(pk2(s1[8], s1[9]), pk2(s1[10], s1[11]), pk2(s1[12], s1[13]), pk2(s1[14], s1[15]));
#pragma unroll
    for (int sub = 0; sub < 2; ++sub)
#pragma unroll
      for (int st = 0; st < 2; ++st) {
        const char* vb = base + voff + (sub * 32 + st * 16) * 2;
        bf16x8 v0 = cat8(*(const uint2*)vb, *(const uint2*)(vb + 16));
        bf16x8 v1 = cat8(*(const uint2*)(vb + 4352), *(const uint2*)(vb + 4352 + 16));
        O0 = mfma(v0, pf[sub][st], O0); O1 = mfma(v1, pf[sub][st], O1);
      }
  };
  for (int i = 0; i < ntile; i += 2) {
    if (i + 2 < ntile) A_LOAD(rk0, rv0, kt_lo + i + 2)
    compute(lds, kt_lo + i);
    A_STORE(rk1, rv1, 1)
    __syncthreads();
    if (i + 3 < ntile) A_LOAD(rk1, rv1, kt_lo + i + 3)
    compute(lds + 17920, kt_lo + i + 1);
    if (i + 2 < ntile) A_STORE(rk0, rv0, 0)
    __syncthreads();
  }
#undef A_LOAD
#undef A_STORE
  float lt = l + __shfl_xor(l, 32);
  if (WIN) lt += ex2(sink2 - m);
  const float inv = 1.f / lt;
  u16* op = mix + (size_t)(brow0 + qi) * DM + outcol + 4 * h;
#pragma unroll
  for (int g = 0; g < 4; ++g) {
    *(uint2*)(op + 8 * g) = make_uint2(pk2(O0[4 * g] * inv, O0[4 * g + 1] * inv), pk2(O0[4 * g + 2] * inv, O0[4 * g + 3] * inv));
    *(uint2*)(op + 32 + 8 * g) = make_uint2(pk2(O1[4 * g] * inv, O1[4 * g + 1] * inv), pk2(O1[4 * g + 2] * inv, O1[4 * g + 3] * inv));
  }
}

DI void xattn_tile(const u16* __restrict__ xq, const u16* __restrict__ memk, const u16* __restrict__ memvt, u16* __restrict__ o, int m0, int hx, char* lds) {
  int tid_ = threadIdx.x; asm volatile("" : "+v"(tid_)); const int tid = tid_, lane = tid & 63, wid = tid >> 6, r = lane & 31, h = lane >> 5;
  const int qg = wid >> 1, dh = wid & 1;
  const int row = m0 + qg * 32 + r;
  const int bm = m0 < MP ? (m0 >> 13) : 4 + ((m0 - MP) >> 11);
  {
    const u16* qp = xq + (size_t)(m0 + (tid >> 5)) * DM + hx * 256 + (tid & 31) * 8;
    char* qd = lds + 35328 + (tid >> 5) * 528 + (tid & 31) * 16;
#pragma unroll
    for (int i = 0; i < 8; ++i) *(uint4*)(qd + i * 8 * 528) = *(const uint4*)(qp + (size_t)(8 * i) * DM);
  }
  const u16* gk = memk + (size_t)(bm * 256 + (tid >> 5)) * DM + hx * 256 + (tid & 31) * 8;
  const u16* gv = memvt + (size_t)(bm * 1024 + hx * 256 + (tid >> 2)) * 256 + (tid & 3) * 8;
  const int skoff = (tid >> 5) * 528 + (tid & 31) * 16, svoff = 16896 + (tid >> 2) * 72 + (tid & 3) * 16;
  u32x16 rk, rv;
#pragma unroll
  for (int i = 0; i < 4; ++i) { LD4(rk, i, gk + (size_t)(8 * i) * DM); LD4(rv, i, gv + (size_t)(64 * i) * 256); }
  f32x16 O[4];
#pragma unroll
  for (int i = 0; i < 4; ++i) O[i] = zero16();
  float m = -1e30f, l = 0.f;
  const int koff = r * 528 + h * 16, qoff = 35328 + (qg * 32 + r) * 528 + h * 16, voff = 16896 + (dh * 128 + r) * 72 + h * 8;
#pragma unroll 1
  for (int kt = 0; kt < 8; ++kt) {
    __syncthreads();
#pragma unroll
    for (int i = 0; i < 4; ++i) {
      *(uint4*)(lds + skoff + i * 8 * 528) = GET4(rk, i);
      *(uint2*)(lds + svoff + i * 64 * 72) = GETLO(rv, i); *(uint2*)(lds + svoff + i * 64 * 72 + 8) = GETHI(rv, i);
    }
    __syncthreads();
    if (kt < 7) {
      const int k0 = (kt + 1) * 32;
#pragma unroll
      for (int i = 0; i < 4; ++i) { LD4(rk, i, gk + (size_t)(k0 + 8 * i) * DM); LD4(rv, i, gv + (size_t)(64 * i) * 256 + k0); }
    }
    f32x16 s0 = zero16();
#pragma unroll
    for (int s = 0; s < 16; ++s) { bf16x8 kf = *(const bf16x8*)(lds + koff + s * 32); bf16x8 qf = *(const bf16x8*)(lds + qoff + s * 32); s0 = mfma(kf, qf, s0); }
    float mx = s0[0];
#pragma unroll
    for (int i = 1; i < 16; ++i) mx = fmaxf(mx, s0[i]);
    mx = fmaxf(mx, __shfl_xor(mx, 32));
    const float mn = fmaxf(m, mx), alpha = ex2(m - mn);
    m = mn;
    float ps = 0.f;
#pragma unroll
    for (int i = 0; i < 16; ++i) { s0[i] = ex2(s0[i] - mn); ps += s0[i]; }
    l = l * alpha + ps;
#pragma unroll
    for (int dt = 0; dt < 4; ++dt)
#pragma unroll
      for (int i = 0; i < 16; ++i) O[dt][i] *= alpha;
    bf16x8 pf[2];
    pf[0] = mk8(pk2(s0[0], s0[1]), pk2(s0[2], s0[3]), pk2(s0[4], s0[5]), pk2(s0[6], s0[7]));
    pf[1] = mk8(pk2(s0[8], s0[9]), pk2(s0[10], s0[11]), pk2(s0[12], s0[13]), pk2(s0[14], s0[15]));
#pragma unroll
    for (int dt = 0; dt < 4; ++dt)
#pragma unroll
      for (int st = 0; st < 2; ++st) {
        const char* vb = lds + voff + dt * 32 * 72 + st * 32;
        bf16x8 vf = cat8(*(const uint2*)vb, *(const uint2*)(vb + 16));
        O[dt] = mfma(vf, pf[st], O[dt]);
      }
  }
  const float inv = 1.f / (l + __shfl_xor(l, 32));
  u16* op = o + (size_t)row * DM + hx * 256 + dh * 128 + 4 * h;
#pragma unroll
  for (int dt = 0; dt < 4; ++dt)
#pragma unroll
    for (int g = 0; g < 4; ++g)
      *(uint2*)(op + dt * 32 + 8 * g) = make_uint2(pk2(O[dt][4 * g] * inv, O[dt][4 * g + 1] * inv), pk2(O[dt][4 * g + 2] * inv, O[dt][4 * g + 3] * inv));
}

DI void ret_kv_tile(const u16* __restrict__ proj, const u16* __restrict__ vt, u16* __restrict__ st, int cgi, int hc, float lgf2, float lgb2, char* lds) {
  int tid_ = threadIdx.x; asm volatile("" : "+v"(tid_)); const int tid = tid_;
  float* KF = (float*)lds;
  float* VT = KF + 128 * 64;
  float* WF = VT + 64 * 132;
  float* WB = WF + 128;
  const int row0 = cgi * 128;
  for (int i = 0; i < 4; ++i) {
    const int c = tid + 256 * i, rr = c >> 3, kc = c & 7;
    const uint4 u = *(const uint4*)(proj + (size_t)(row0 + rr) * PROJ_W + C_KC + hc * 64 + kc * 8);
    float* d = KF + rr * 64 + kc * 8;
    d[0] = bflo(u.x); d[1] = bfhi(u.x); d[2] = bflo(u.y); d[3] = bfhi(u.y); d[4] = bflo(u.z); d[5] = bfhi(u.z); d[6] = bflo(u.w); d[7] = bfhi(u.w);
    const int e = c >> 4, cc = (c & 15) * 8;
    const uint4 w = *(const uint4*)(vt + (size_t)(256 + hc * 64 + e) * M_TOK + row0 + cc);
    float* dv = VT + e * 132 + cc;
    dv[0] = bflo(w.x); dv[1] = bfhi(w.x); dv[2] = bflo(w.y); dv[3] = bfhi(w.y); dv[4] = bflo(w.z); dv[5] = bfhi(w.z); dv[6] = bflo(w.w); dv[7] = bfhi(w.w);
  }
  if (tid < 128) { WF[tid] = ex2(lgf2 * (float)(127 - tid)); WB[tid] = ex2(lgb2 * (float)tid); }
  __syncthreads();
  const int e = tid >> 2, d0 = (tid & 3) * 16;
  float af[16], ab[16];
#pragma unroll
  for (int j = 0; j < 16; ++j) { af[j] = 0.f; ab[j] = 0.f; }
  for (int c = 0; c < 128; ++c) {
    const float vv = VT[e * 132 + c], vf = vv * WF[c], vb = vv * WB[c];
    const float* kp = KF + c * 64 + d0;
#pragma unroll
    for (int j = 0; j < 16; ++j) { const float kk = kp[j]; af[j] += vf * kk; ab[j] += vb * kk; }
  }
  u16* pf = st + ((size_t)(cgi * 4 + hc)) * 4096 + e * 64 + d0;
  u16* pb = pf + (size_t)384 * 4 * 4096;
  *(uint4*)pf = make_uint4(pk2(af[0], af[1]), pk2(af[2], af[3]), pk2(af[4], af[5]), pk2(af[6], af[7]));
  *(uint4*)(pf + 8) = make_uint4(pk2(af[8], af[9]), pk2(af[10], af[11]), pk2(af[12], af[13]), pk2(af[14], af[15]));
  *(uint4*)pb = make_uint4(pk2(ab[0], ab[1]), pk2(ab[2], ab[3]), pk2(ab[4], ab[5]), pk2(ab[6], ab[7]));
  *(uint4*)(pb + 8) = make_uint4(pk2(ab[8], ab[9]), pk2(ab[10], ab[11]), pk2(ab[12], ab[13]), pk2(ab[14], ab[15]));
}

DI void ret_out_tile(const u16* __restrict__ proj, const u16* __restrict__ vt, const u16* __restrict__ st, u16* __restrict__ mix, const float* __restrict__ gn,
                     int cgi, int hc, float lgf2, float lgb2, char* lds) {
  int tid_ = threadIdx.x; asm volatile("" : "+v"(tid_)); const int tid = tid_, lane = tid & 63, wid = tid >> 6, r = lane & 31, h = lane >> 5;
  const int row0 = cgi * 128;
  for (int i = 0; i < 4; ++i) {
    const int c = tid + 256 * i;
    { const int rr = c >> 3, kc = c & 7; *(uint4*)(lds + rr * 144 + kc * 16) = *(const uint4*)(proj + (size_t)(row0 + rr) * PROJ_W + C_KC + hc * 64 + kc * 8); }
    { const int e = c >> 4, cc = c & 15; const uint4 w = *(const uint4*)(vt + (size_t)(256 + hc * 64 + e) * M_TOK + row0 + cc * 8);
      char* d = lds + 18432 + e * 264 + cc * 16; *(uint2*)d = make_uint2(w.x, w.y); *(uint2*)(d + 8) = make_uint2(w.z, w.w); }
  }
  for (int i = 0; i < 2; ++i) {
    const int c = tid + 256 * i, e = c >> 3, kc = c & 7;
    const u16* sp = st + ((size_t)(cgi * 4 + hc)) * 4096 + e * 64 + kc * 8;
    *(uint4*)(lds + 35328 + e * 144 + kc * 16) = *(const uint4*)sp;
    *(uint4*)(lds + 44544 + e * 144 + kc * 16) = *(const uint4*)(sp + (size_t)384 * 4 * 4096);
  }
  const int a = wid * 32 + r;
  bf16x8 qf[4];
  {
    const u16* qp = proj + (size_t)(row0 + a) * PROJ_W + C_QC + hc * 64 + h * 8;
#pragma unroll
    for (int s = 0; s < 4; ++s) qf[s] = *(const bf16x8*)(qp + s * 16);
  }
  __syncthreads();
  f32x16 O0, O1;
  {
    f32x16 t10 = zero16(), t11 = zero16(), t20 = zero16(), t21 = zero16();
    const int so = r * 144 + h * 16;
#pragma unroll
    for (int s = 0; s < 4; ++s) {
      bf16x8 f0 = *(const bf16x8*)(lds + 35328 + so + s * 32), f1 = *(const bf16x8*)(lds + 35328 + 4608 + so + s * 32);
      bf16x8 b0 = *(const bf16x8*)(lds + 44544 + so + s * 32), b1 = *(const bf16x8*)(lds + 44544 + 4608 + so + s * 32);
      t10 = mfma(f0, qf[s], t10); t11 = mfma(f1, qf[s], t11); t20 = mfma(b0, qf[s], t20); t21 = mfma(b1, qf[s], t21);
    }
    const float df = ex2(lgf2 * (float)(a + 1)), db = ex2(lgb2 * (float)(128 - a));
#pragma unroll
    for (int i = 0; i < 16; ++i) { O0[i] = df * t10[i] + db * t20[i]; O1[i] = df * t11[i] + db * t21[i]; }
  }
  const int koff = r * 144 + h * 16, voff = 18432 + r * 264 + h * 8;
#pragma unroll 1
  for (int kt = 0; kt < 4; ++kt) {
    f32x16 s0 = zero16();
#pragma unroll
    for (int s = 0; s < 4; ++s) { bf16x8 kf = *(const bf16x8*)(lds + koff + kt * 4608 + s * 32); s0 = mfma(kf, qf[s], s0); }
#pragma unroll
    for (int i = 0; i < 16; ++i) {
      const int c = kt * 32 + crow(i, h), df = a - c;
      const float w = df >= 0 ? ex2(lgf2 * (float)df) : ex2(lgb2 * (float)(-df));
      s0[i] *= w;
    }
    bf16x8 p0 = mk8(pk2(s0[0], s0[1]), pk2(s0[2], s0[3]), pk2(s0[4], s0[5]), pk2(s0[6], s0[7]));
    bf16x8 p1 = mk8(pk2(s0[8], s0[9]), pk2(s0[10], s0[11]), pk2(s0[12], s0[13]), pk2(s0[14], s0[15]));
    const char* vb = lds + voff + kt * 64;
    bf16x8 v00 = cat8(*(const uint2*)vb, *(const uint2*)(vb + 16)), v01 = cat8(*(const uint2*)(vb + 32), *(const uint2*)(vb + 48));
    bf16x8 v10 = cat8(*(const uint2*)(vb + 8448), *(const uint2*)(vb + 8448 + 16)), v11 = cat8(*(const uint2*)(vb + 8448 + 32), *(const uint2*)(vb + 8448 + 48));
    O0 = mfma(v00, p0, O0); O0 = mfma(v01, p1, O0); O1 = mfma(v10, p0, O1); O1 = mfma(v11, p1, O1);
  }
  float sm = 0.f;
#pragma unroll
  for (int i = 0; i < 16; ++i) sm += O0[i] + O1[i];
  sm += __shfl_xor(sm, 32);
  const float mean = sm * (1.f / 64.f);
  float sv = 0.f;
#pragma unroll
  for (int i = 0; i < 16; ++i) { O0[i] -= mean; O1[i] -= mean; sv += O0[i] * O0[i] + O1[i] * O1[i]; }
  sv += __shfl_xor(sv, 32);
  const float rstd = rsqrtf(sv * (1.f / 64.f) + EPS);
  const u16* gp = proj + (size_t)(row0 + a) * PROJ_W + C_GC + hc * 64 + 4 * h;
  const float* gnp = gn + hc * 64 + 4 * h;
  u16* op = mix + (size_t)(row0 + a) * DM + 768 + hc * 64 + 4 * h;
#pragma unroll
  for (int g = 0; g < 4; ++g) {
    {
      const uint2 sg = *(const uint2*)(gp + 8 * g); const float4 gg = *(const float4*)(gnp + 8 * g);
      const float o0 = O0[4 * g] * rstd * gg.x * bflo(sg.x), o1 = O0[4 * g + 1] * rstd * gg.y * bfhi(sg.x), o2 = O0[4 * g + 2] * rstd * gg.z * bflo(sg.y), o3 = O0[4 * g + 3] * rstd * gg.w * bfhi(sg.y);
      *(uint2*)(op + 8 * g) = make_uint2(pk2(o0, o1), pk2(o2, o3));
    }
    {
      const uint2 sg = *(const uint2*)(gp + 32 + 8 * g); const float4 gg = *(const float4*)(gnp + 32 + 8 * g);
      const float o0 = O1[4 * g] * rstd * gg.x * bflo(sg.x), o1 = O1[4 * g + 1] * rstd * gg.y * bfhi(sg.x), o2 = O1[4 * g + 2] * rstd * gg.z * bflo(sg.y), o3 = O1[4 * g + 3] * rstd * gg.w * bfhi(sg.y);
      *(uint2*)(op + 32 + 8 * g) = make_uint2(pk2(o0, o1), pk2(o2, o3));
    }
  }
}

DI void norm_mix_tile(u16* __restrict__ mix, const float* __restrict__ ga, const float* __restrict__ gb, int row0) {
  int tid_ = threadIdx.x; asm volatile("" : "+v"(tid_)); const int tid = tid_, lane = tid & 63, wid = tid >> 6;
  const int l5 = lane & 31;
  float gA[8], gB[8];
#pragma unroll
  for (int j = 0; j < 8; ++j) { gA[j] = ga[lane * 8 + j]; gB[j] = gb[l5 * 8 + j]; }
  for (int rb = 0; rb < 8; rb += 4) {
    uint4 ua[4], ub[4];
#pragma unroll
    for (int k = 0; k < 4; ++k) { const u16* p = mix + (size_t)(row0 + wid * 8 + rb + k) * DM; ua[k] = *(const uint4*)(p + lane * 8); ub[k] = *(const uint4*)(p + 512 + l5 * 8); }
#pragma unroll
    for (int k = 0; k < 4; ++k) {
      u16* p = mix + (size_t)(row0 + wid * 8 + rb + k) * DM;
      {
        const uint4 u = ua[k];
        float v[8] = {bflo(u.x), bfhi(u.x), bflo(u.y), bfhi(u.y), bflo(u.z), bfhi(u.z), bflo(u.w), bfhi(u.w)};
        float ss = 0.f;
#pragma unroll
        for (int j = 0; j < 8; ++j) ss += v[j] * v[j];
        for (int o = 32; o; o >>= 1) ss += __shfl_xor(ss, o);
        const float rs = rsqrtf(ss * (1.f / 512.f) + EPS);
        *(uint4*)(p + lane * 8) = make_uint4(pk2(v[0] * rs * gA[0], v[1] * rs * gA[1]), pk2(v[2] * rs * gA[2], v[3] * rs * gA[3]), pk2(v[4] * rs * gA[4], v[5] * rs * gA[5]), pk2(v[6] * rs * gA[6], v[7] * rs * gA[7]));
      }
      {
        const uint4 u = ub[k];
        float v[8] = {bflo(u.x), bfhi(u.x), bflo(u.y), bfhi(u.y), bflo(u.z), bfhi(u.z), bflo(u.w), bfhi(u.w)};
        float ss = 0.f;
#pragma unroll
        for (int j = 0; j < 8; ++j) ss += v[j] * v[j];
        for (int o = 16; o; o >>= 1) ss += __shfl_xor(ss, o);
        const float rs = rsqrtf(ss * (1.f / 256.f) + EPS);
        if (lane < 32)
          *(uint4*)(p + 512 + l5 * 8) = make_uint4(pk2(v[0] * rs * gB[0], v[1] * rs * gB[1]), pk2(v[2] * rs * gB[2], v[3] * rs * gB[3]), pk2(v[4] * rs * gB[4], v[5] * rs * gB[5]), pk2(v[6] * rs * gB[6], v[7] * rs * gB[7]));
      }
    }
  }
}

DI void conv_tile(const float* __restrict__ src, int K, int N, const float* __restrict__ g, u16* __restrict__ dst, int k0, int n0, int dstrow0, char* lds) {
  int tid_ = threadIdx.x; asm volatile("" : "+v"(tid_)); const int tid = tid_;
  float* S = (float*)lds;
  const int nn = tid & 63, kq = tid >> 6;
#pragma unroll
  for (int i = 0; i < 16; ++i) {
    const int kk = kq + 4 * i;
    float v = src[(size_t)(k0 + kk) * N + n0 + nn];
    if (g) v *= g[k0 + kk];
    S[nn * 65 + kk] = v;
  }
  __syncthreads();
  const int n2 = tid >> 2, kk2 = (tid & 3) * 16;
  const float* sp = S + n2 * 65 + kk2;
  u16* dp = dst + (size_t)(dstrow0 + n2) * K + k0 + kk2;
  *(uint4*)dp = make_uint4(pk2(sp[0], sp[1]), pk2(sp[2], sp[3]), pk2(sp[4], sp[5]), pk2(sp[6], sp[7]));
  *(uint4*)(dp + 8) = make_uint4(pk2(sp[8], sp[9]), pk2(sp[10], sp[11]), pk2(sp[12], sp[13]), pk2(sp[14], sp[15]));
  __syncthreads();
}

DI void conv_job(const Params& p, u16* W, int l, int q, char* lds) {
  u16* Wl = W + (size_t)l * W_LAYER;
  const float* src; const float* g = nullptr; u16* dst; int K = 1024, N, kt, nb, drow;
  if (q < 576) { N = 2304; src = p.w_in + (size_t)l * 1024 * 2304; g = p.g_mix + l * 1024; dst = Wl + W_IN; kt = q / 36; nb = q % 36;
    int db_;
    if (nb < 10) db_ = nb; else if (nb < 12) db_ = nb + 18; else if (nb < 18) db_ = nb - 2; else if (nb < 20) db_ = nb + 12; else if (nb < 28) db_ = nb - 4; else if (nb < 32) db_ = nb + 4; else db_ = nb - 8;
    drow = db_ * 64; }
  else if ((q -= 576) < 256) { N = 1024; src = p.w_out + (size_t)l * 1024 * 1024; dst = Wl + W_OUT; kt = q / 16; nb = q % 16; drow = nb * 64; }
  else if ((q -= 256) < 256) { N = 1024; src = p.w_xq + (size_t)l * 1024 * 1024; g = p.g_cross + l * 1024; dst = Wl + W_XQ; kt = q / 16; nb = q % 16; drow = nb * 64; }
  else if ((q -= 256) < 256) { N = 1024; src = p.w_xk + (size_t)l * 1024 * 1024; g = p.g_mem + l * 1024; dst = Wl + W_XKV; kt = q / 16; nb = q % 16; drow = nb * 64; }
  else if ((q -= 256) < 256) { N = 1024; src = p.w_xv + (size_t)l * 1024 * 1024; g = p.g_mem + l * 1024; dst = Wl + W_XKV; kt = q / 16; nb = q % 16; drow = 1024 + nb * 64; }
  else if ((q -= 256) < 256) { N = 1024; src = p.w_xo + (size_t)l * 1024 * 1024; dst = Wl + W_XO; kt = q / 16; nb = q % 16; drow = nb * 64; }
  else if ((q -= 256) < 704) { N = DFF; src = p.w_gate + (size_t)l * 1024 * DFF; g = p.g_ffn + l * 1024; dst = Wl + W_GU; kt = q / 44; nb = q % 44; drow = nb * 128; }
  else if ((q -= 704) < 704) { N = DFF; src = p.w_up + (size_t)l * 1024 * DFF; g = p.g_ffn + l * 1024; dst = Wl + W_GU; kt = q / 44; nb = q % 44; drow = nb * 128 + 64; }
  else { q -= 704; K = DFF; N = 1024; src = p.w_down + (size_t)l * DFF * 1024; dst = Wl + W_DN; kt = q / 16; nb = q % 16; drow = nb * 64; }
  conv_tile(src, K, N, g, dst, kt * 64, nb * 64, drow, lds);
}

__global__ void __launch_bounds__(NT, 2) mega(Params p) {
  __shared__ __attribute__((aligned(16))) char lds[LDS_BYTES];
  __shared__ int s_tile;
  cg::grid_group grid = cg::this_grid();
  unsigned tgt = 0;
  const int tid = threadIdx.x, lane = tid & 63, wid = tid >> 6;
  const int gw = blockIdx.x * 4 + wid, nw = gridDim.x * 4;
  unsigned* ctrl = (unsigned*)(p.ws + OFF_CTRL);
  unsigned* qctr = ctrl + 512;
  int qn = 0;
  float* ssqA = (float*)(p.ws + OFF_SSQ2);
  float* ssqB = ssqA + (size_t)M_TOK * 8; float* ssqC = ssqB + (size_t)M_TOK * 8; float* ssq_mem = ssqC + (size_t)M_TOK * 8;
  h16x2* tab_seq = (h16x2*)(p.ws + OFF_TAB);
  h16x2* tab_ax = tab_seq + 8192 * 32;
  u16* memb = (u16*)(p.ws + OFF_MEMB);
  u16* memk = (u16*)(p.ws + OFF_MEMK);
  u16* memvt = (u16*)(p.ws + OFF_MEMVT);
  u16* st = (u16*)(p.ws + OFF_ST);
  u16* W = (u16*)(p.ws + OFF_W);
  u16* rega = (u16*)(p.ws + OFF_REGA);
  u16* x16 = (u16*)(p.ws + OFF_MIXB);
  u16* mixb = (u16*)p.out;
  u16* proj = rega;
  u16* vt = rega + (size_t)M_TOK * PROJ_W;
  u16* xqb = rega + (size_t)M_TOK * DM;
  u16* act1 = rega;
  u16* act2 = (u16*)p.out + (size_t)M_TOK * DM;

  {
    const int gt = blockIdx.x * NT + tid, ngt = gridDim.x * NT;
    for (int i = gt; i < 8192 * 32; i += ngt) {
      const int t = i >> 5, f = i & 31;
      {
        double inv = 1.0; for (int k = 0; k < f; ++k) inv *= 0.7498942093324559;
        double rev = (double)t * inv * 0.15915494309189535; rev -= rint(rev);
        const float rf = (float)rev; tab_seq[i] = (h16x2){(_Float16)__builtin_amdgcn_cosf(rf), (_Float16)__builtin_amdgcn_sinf(rf)};
      }
      {
        const int pos = f < 16 ? (t >> 6) : (t & 63); const int ff = f & 15;
        double inv = 1.0; for (int k = 0; k < ff; ++k) inv *= 0.5623413251903491;
        double rev = (double)pos * inv * 0.15915494309189535; rev -= rint(rev);
        const float rf = (float)rev; tab_ax[i] = (h16x2){(_Float16)__builtin_amdgcn_cosf(rf), (_Float16)__builtin_amdgcn_sinf(rf)};
      }
    }
    for (int rr = gw; rr < M_TOK + NMEM; rr += nw) {
      const bool isx = rr < M_TOK;
      const float* src; u16* db; float* sq;
      if (isx) { src = rr < MP ? p.x_prompt + (size_t)rr * DM : p.x_sample + (size_t)(rr - MP) * DM; db = x16 + (size_t)rr * DM; sq = ssqA + (size_t)rr * 8; }
      else { const int mr = rr - M_TOK; src = mr < 1024 ? p.mem_prompt + (size_t)mr * DM : p.mem_sample + (size_t)(mr - 1024) * DM; db = memb + (size_t)mr * DM; sq = ssq_mem + (size_t)mr * 8; }
      float s = 0.f;
      for (int c = lane * 4; c < DM; c += 256) {
        const float4 v = *(const float4*)(src + c);
        s += v.x * v.x + v.y * v.y + v.z * v.z + v.w * v.w;
        *(uint2*)(db + c) = make_uint2(pk2(v.x, v.y), pk2(v.z, v.w));
      }
      for (int o = 32; o; o >>= 1) s += __shfl_xor(s, o);
      if (lane < 8) sq[lane] = lane == 0 ? s : 0.f;
    }
    for (int t = blockIdx.x; t < 3968; t += gridDim.x) conv_job(p, W, 0, t, lds);
  }
  if (p.ws == nullptr) grid.sync();
  grid_bar(ctrl, tgt);

  for (int l = 0; l < 4; ++l) {
    const u16* Wl = W + (size_t)l * W_LAYER;
    {
      EpiArgs ea{}; ea.ssq_in = ssqA; ea.proj = proj; ea.vt = vt; ea.tab_seq = tab_seq; ea.tab_ax = tab_ax;
      ea.qn = p.a_q_norm + l * 64; ea.kn = p.a_k_norm + l * 64;
      EpiArgs eb{}; eb.ssq_in = ssq_mem; eb.memk = memk; eb.memvt = memvt;
      unsigned* qc = qctr + 8 * (qn++);
      (void)qc;
      run_pairs(216, [&](int x, int pt, int mb) {
        const int sg = pt / 72, rem = pt % 72, nt = (rem >> 3) * 2 + mb, mt = x * 24 + sg * 8 + (rem & 7);
        gemm_tile256<1>(x16 + (size_t)mt * 256 * DM, DM, Wl + W_IN + (size_t)nt * 128 * DM, DM, DM, mt * 256, nt * 128, lds, ea); });
      unsigned* qc2 = qctr + 8 * (qn++);
      run_queues(qc2, &s_tile, [](int x) { return x < 6 ? 32 : 0; }, [&](int x, int q) {
        const int nt = q >> 1, mt = x * 2 + (q & 1);
        gemm_tile256<5>(memb + (size_t)mt * 256 * DM, DM, Wl + W_XKV + (size_t)nt * 128 * DM, DM, DM, mt * 256, nt * 128, lds, eb); });
    }
    grid_bar(ctrl, tgt);
    {
      unsigned* qc = qctr + 8 * (qn++);
      float gq = 0.f, gk = 0.f;
      for (int i = 0; i < 64; ++i) { gq = fmaxf(gq, fabsf(p.a_q_norm[l * 64 + i])); gk = fmaxf(gk, fabsf(p.a_k_norm[l * 64 + i])); }
      const bool nomax = 64.f * gq * gk * (0.125f * LOG2E) < 60.f;
      const int nq2 = l < 3 ? 768 + 496 : 768;
      run_queues(qc, &s_tile, [=](int) { return nq2; }, [&](int x, int q) {
        if (q >= 768) { conv_job(p, W, l + 1, x * 496 + (q - 768), lds); return; }
        if (q < 256) { const int b = x >> 1, kvh = x & 1, qb = q >> 2, g = q & 3;
          if (nomax) attn64_tile<false, true>(proj, vt, mixb, b * 8192, 8192, qb * 128, C_QA + (kvh * 4 + g) * 64, C_KA + kvh * 64, kvh * 64, (kvh * 4 + g) * 64, 0.f, lds);
          else attn64_tile<false>(proj, vt, mixb, b * 8192, 8192, qb * 128, C_QA + (kvh * 4 + g) * 64, C_KA + kvh * 64, kvh * 64, (kvh * 4 + g) * 64, 0.f, lds); }
        else if (q < 384) { const int u = q - 256, pr = 2 * x + (u >> 6), b = pr >> 1, kvh = pr & 1, qb = (u >> 2) & 15, g = u & 3;
          if (nomax) attn64_tile<false, true>(proj, vt, mixb, MP + b * 2048, 2048, qb * 128, C_QA + (kvh * 4 + g) * 64, C_KA + kvh * 64, kvh * 64, (kvh * 4 + g) * 64, 0.f, lds);
          else attn64_tile<false>(proj, vt, mixb, MP + b * 2048, 2048, qb * 128, C_QA + (kvh * 4 + g) * 64, C_KA + kvh * 64, kvh * 64, (kvh * 4 + g) * 64, 0.f, lds); }
        else if (q < 576) { const int u = q - 384, hb = u & 3, cgi = x * 48 + (u >> 2); int brow0, T, q0;
          if (cgi < 256) { brow0 = (cgi >> 6) * 8192; T = 8192; q0 = (cgi & 63) * 128; } else { const int c2 = cgi - 256; brow0 = MP + (c2 >> 4) * 2048; T = 2048; q0 = (c2 & 15) * 128; }
          const int kvh = hb >> 1;
          attn64_tile<true>(proj, vt, mixb, brow0, T, q0, C_QB + hb * 64, C_KB + kvh * 64, 128 + kvh * 64, 512 + hb * 64, p.b_sink[l * 4 + hb] * LOG2E, lds); }
        else { const int u = q - 576, hc = u & 3, cgi = x * 48 + (u >> 2);
          ret_kv_tile(proj, vt, st, cgi, hc, -expf(p.c_decay_fwd[l * 4 + hc]) * LOG2E, -expf(p.c_decay_bwd[l * 4 + hc]) * LOG2E, lds); } });
    }
    grid_bar(ctrl, tgt);
    {
      const int gt = blockIdx.x * NT + tid, ngt = gridDim.x * NT;
      for (int it = gt; it < 49152; it += ngt) {
        const int el = it & 511, hc = (it >> 9) & 3, dir = (it >> 11) & 1, seq = it >> 12;
        const int nc = seq < 4 ? 64 : 16, cg0 = seq < 4 ? seq * 64 : 256 + (seq - 4) * 16;
        const float dec = ex2(-expf((dir ? p.c_decay_bwd : p.c_decay_fwd)[l * 4 + hc]) * LOG2E * 128.f);
        float S[8];
#pragma unroll
        for (int j = 0; j < 8; ++j) S[j] = 0.f;
        u16* base = st + ((size_t)dir * 384 * 4 + hc) * 4096 + el * 8;
        for (int i = 0; i < nc; i += 4) {
          u32x16 tm;
#pragma unroll
          for (int k = 0; k < 4; ++k) { const int n = dir ? nc - 1 - (i + k) : (i + k); LD4(tm, k, base + (size_t)(cg0 + n) * 4 * 4096); }
#pragma unroll
          for (int k = 0; k < 4; ++k) {
            const int n = dir ? nc - 1 - (i + k) : (i + k);
            *(uint4*)(base + (size_t)(cg0 + n) * 4 * 4096) = make_uint4(pk2(S[0], S[1]), pk2(S[2], S[3]), pk2(S[4], S[5]), pk2(S[6], S[7]));
            const uint4 tk = GET4(tm, k);
            S[0] = dec * S[0] + bflo(tk.x); S[1] = dec * S[1] + bfhi(tk.x); S[2] = dec * S[2] + bflo(tk.y); S[3] = dec * S[3] + bfhi(tk.y);
            S[4] = dec * S[4] + bflo(tk.z); S[5] = dec * S[5] + bfhi(tk.z); S[6] = dec * S[6] + bflo(tk.w); S[7] = dec * S[7] + bfhi(tk.w);
          }
        }
      }
    }
    grid_bar(ctrl, tgt);
    {
      unsigned* qc = qctr + 8 * (qn++);
      run_queues(qc, &s_tile, [](int) { return 384; }, [&](int x, int q) {
        if (q < 192) { const int hc = q & 3, cgi = x * 48 + (q >> 2);
          ret_out_tile(proj, vt, st, mixb, p.c_gn + l * 256, cgi, hc, -expf(p.c_decay_fwd[l * 4 + hc]) * LOG2E, -expf(p.c_decay_bwd[l * 4 + hc]) * LOG2E, lds); }
        else norm_mix_tile(mixb, p.a_out_norm + l * 512, p.b_out_norm + l * 256, (x * 192 + q - 192) * 32); });
    }
    grid_bar(ctrl, tgt);
    {
      EpiArgs ea{}; ea.xb = x16; ea.ssq_out = ssqB;
      unsigned* qc = qctr + 8 * (qn++);
      (void)qc;
      run_pairs(96, [&](int x, int pt, int mb) {
        const int nt = ((pt >> 3) & 3) * 2 + mb, mt = x * 24 + (pt >> 5) * 8 + (pt & 7);
        gemm_tile256<2>(mixb + (size_t)mt * 256 * DM, DM, Wl + W_OUT + (size_t)nt * 128 * DM, DM, DM, mt * 256, nt * 128, lds, ea); });
    }
    grid_bar(ctrl, tgt);
    {
      EpiArgs ea{}; ea.ssq_in = ssqB; ea.o16 = xqb;
      unsigned* qc = qctr + 8 * (qn++);
      (void)qc;
      run_pairs(96, [&](int x, int pt, int mb) {
        const int nt = ((pt >> 3) & 3) * 2 + mb, mt = x * 24 + (pt >> 5) * 8 + (pt & 7);
        gemm_tile256<3>(x16 + (size_t)mt * 256 * DM, DM, Wl + W_XQ + (size_t)nt * 128 * DM, DM, DM, mt * 256, nt * 128, lds, ea); });
    }
    grid_bar(ctrl, tgt);
    {
      unsigned* qc = qctr + 8 * (qn++);
      run_queues(qc, &s_tile, [](int) { return 384; }, [&](int x, int q) { xattn_tile(xqb, memk, memvt, mixb, (x * 96 + (q >> 2)) * 64, q & 3, lds); });
    }
    grid_bar(ctrl, tgt);
    {
      EpiArgs ea{}; ea.xb = x16; ea.ssq_out = ssqC;
      unsigned* qc = qctr + 8 * (qn++);
      (void)qc;
      run_pairs(96, [&](int x, int pt, int mb) {
        const int nt = ((pt >> 3) & 3) * 2 + mb, mt = x * 24 + (pt >> 5) * 8 + (pt & 7);
        gemm_tile256<2>(mixb + (size_t)mt * 256 * DM, DM, Wl + W_XO + (size_t)nt * 128 * DM, DM, DM, mt * 256, nt * 128, lds, ea); });
    }
    grid_bar(ctrl, tgt);
    {
      EpiArgs ea{}; ea.ssq_in = ssqC; ea.o16 = act1; ea.o16b = act2;
      unsigned* qc = qctr + 8 * (qn++);
      (void)qc;
      run_pairs(528, [&](int x, int pt, int mb) {
        const int sg = pt / 176, rem = pt % 176, nt = (rem >> 3) * 2 + mb, mt = x * 24 + sg * 8 + (rem & 7), m0 = mt * 256;
        gemm_tile256<4>(x16 + (size_t)m0 * DM, DM, Wl + W_GU + (size_t)nt * 128 * DM, DM, DM, m0, nt * 128, lds, ea); });
    }
    grid_bar(ctrl, tgt);
    {
      EpiArgs ea{}; ea.xb = x16; ea.ssq_out = ssqA;
      unsigned* qc = qctr + 8 * (qn++);
      (void)qc;
      run_pairs(192, [&](int x, int pt, int mb) {
        const int nt = ((pt >> 3) & 3) * 2 + mb, mt = x * 48 + (pt >> 5) * 8 + (pt & 7), m0 = mt * 128;
        gemm_tile<2>(act1 + (size_t)m0 * 2432, 2432, Wl + W_DN + (size_t)nt * 128 * DFF, DFF, DFF, m0, nt * 128, lds, ea, act2 + (size_t)m0 * 384, 384, 38); });
    }
    grid_bar(ctrl, tgt);
  }
  {
    for (int rr = gw; rr < M_TOK; rr += nw) {
      const float4 q0 = *(const float4*)(ssqA + (size_t)rr * 8), q1 = *(const float4*)(ssqA + (size_t)rr * 8 + 4);
      const float rs = rsqrtf((((q0.x + q0.y) + (q0.z + q0.w)) + ((q1.x + q1.y) + (q1.z + q1.w))) * (1.f / DM) + EPS);
      for (int c = lane * 4; c < DM; c += 256) {
        const uint2 u = *(const uint2*)(x16 + (size_t)rr * DM + c);
        float4 v = make_float4(bflo(u.x), bfhi(u.x), bflo(u.y), bfhi(u.y));
        const float4 g = *(const float4*)(p.g_final + c);
        v.x *= rs * g.x; v.y *= rs * g.y; v.z *= rs * g.z; v.w *= rs * g.w;
        *(float4*)(p.out + (size_t)rr * DM + c) = v;
      }
    }
  }
}

extern "C" void kernel_launch(void* const* d_in, const int* in_sizes, int n_in, void* d_out, int out_size, void* d_ws, size_t ws_size, hipStream_t stream) {
  static int grid_blocks = 0;
  if (!grid_blocks) {
    int dev = 0, cus = 0, per_cu = 0;
    (void)hipGetDevice(&dev);
    (void)hipDeviceGetAttribute(&cus, hipDeviceAttributeMultiprocessorCount, dev);
    (void)hipOccupancyMaxActiveBlocksPerMultiprocessor(&per_cu, mega, NT, 0);
    if (per_cu > 2) per_cu = 2;
    grid_blocks = cus * per_cu;
  }
  if (ws_size < WS_NEED) { fprintf(stderr, "workspace too small: %zu < %zu\n", ws_size, (size_t)WS_NEED); return; }
  Params p{};
  const float** pp = (const float**)&p;
  for (int i = 0; i < 26; ++i) pp[i] = (const float*)d_in[i];
  p.out = (float*)d_out; p.ws = (char*)d_ws;
  (void)hipMemsetAsync(d_ws, 0, 4096, stream);
  void* args[] = {&p};
  hipError_t e = hipLaunchCooperativeKernel((void*)mega, dim3(grid_blocks), dim3(NT), args, 0, stream);
  if (e != hipSuccess) fprintf(stderr, "coop launch failed: %s (grid %d)\n", hipGetErrorString(e), grid_blocks);
}
```

```cpp
#include <hip/hip_runtime.h>
#include <hip/hip_cooperative_groups.h>
#include <stdint.h>
#include <stdio.h>
namespace cg = cooperative_groups;

#define NT 256
#define DI __device__ __forceinline__
typedef unsigned short u16;
typedef short bf16x8 __attribute__((ext_vector_type(8)));
typedef float f32x16 __attribute__((ext_vector_type(16)));
typedef __bf16 bf16x2_t __attribute__((ext_vector_type(2)));
typedef float f32x2_t __attribute__((ext_vector_type(2)));
typedef _Float16 h16x2 __attribute__((ext_vector_type(2)));
typedef unsigned u32x16 __attribute__((ext_vector_type(16)));
typedef unsigned u32x8 __attribute__((ext_vector_type(8)));
#define LD4(vec, i, ptr) do { const uint4 t_ = *(const uint4*)(ptr); vec[4 * (i)] = t_.x; vec[4 * (i) + 1] = t_.y; vec[4 * (i) + 2] = t_.z; vec[4 * (i) + 3] = t_.w; } while (0)
#define GET4(vec, i) make_uint4(vec[4 * (i)], vec[4 * (i) + 1], vec[4 * (i) + 2], vec[4 * (i) + 3])
#define GETLO(vec, i) make_uint2(vec[4 * (i)], vec[4 * (i) + 1])
#define GETHI(vec, i) make_uint2(vec[4 * (i) + 2], vec[4 * (i) + 3])

constexpr int M_TOK = 49152, MP = 32768, DM = 1024, DFF = 2816, NMEM = 3072, HALF_M = 24576;
constexpr int PROJ_W = 1792;
constexpr int C_QA = 0, C_KA = 512, C_QB = 640, C_KB = 896, C_QC = 1024, C_KC = 1280, C_GC = 1536;
constexpr float EPS = 1e-6f;
constexpr float LOG2E = 1.4426950408889634f;
constexpr size_t MiB = 1048576;
constexpr size_t OFF_CTRL = 0, OFF_SSQ = 65536, OFF_TAB = 4 * MiB, OFF_MEMB = 8 * MiB, OFF_MEMK = 14 * MiB, OFF_MEMVT = 20 * MiB,
                 OFF_ST = 26 * MiB, OFF_W = 50 * MiB, OFF_REGA = 174 * MiB, OFF_MIXB = 402 * MiB, OFF_SSQ2 = 498 * MiB, WS_NEED = 504 * MiB;
constexpr size_t W_LAYER = 16252928, W_IN = 0, W_OUT = 2359296, W_XQ = 3407872, W_XKV = 4456448, W_XO = 6553600, W_GU = 7602176, W_DN = 13369344;
constexpr int LDS_BYTES = 73728;

struct Params {
  const float *x_prompt, *x_sample, *mem_prompt, *mem_sample, *g_mix, *w_in, *a_q_norm, *a_k_norm, *a_out_norm, *b_sink, *b_out_norm,
      *c_decay_fwd, *c_decay_bwd, *c_gn, *w_out, *g_cross, *g_mem, *w_xq, *w_xk, *w_xv, *w_xo, *g_ffn, *w_gate, *w_up, *w_down, *g_final;
  float* out; char* ws;
};

struct EpiArgs {
  const float* ssq_in; u16* proj; u16* vt; const h16x2* tab_seq; const h16x2* tab_ax; const float* qn; const float* kn;
  float* x; u16* xb; float* ssq_out; u16* o16; u16* o16b; int row_off; u16* memk; u16* memvt;
};

DI unsigned pk2(float a, float b) { f32x2_t v = {a, b}; bf16x2_t r = __builtin_convertvector(v, bf16x2_t); return __builtin_bit_cast(unsigned, r); }
DI float bflo(unsigned u) { return __uint_as_float(u << 16); }
DI float bfhi(unsigned u) { return __uint_as_float(u & 0xffff0000u); }
DI int crow(int i, int h) { return (i & 3) + 8 * (i >> 2) + 4 * h; }
DI float ex2(float x) { return __builtin_amdgcn_exp2f(x); }
DI float max3f(float a, float b, float c) { float d; asm("v_max3_f32 %0, %1, %2, %3" : "=v"(d) : "v"(a), "v"(b), "v"(c)); return d; }
DI float max3f_after_mfma(float a, float b, float c) { float d; asm volatile("s_nop 11\n\tv_max3_f32 %0, %1, %2, %3" : "=v"(d) : "v"(a), "v"(b), "v"(c)); return d; }
DI f32x16 mfma(bf16x8 a, bf16x8 b, f32x16 c) { return __builtin_amdgcn_mfma_f32_32x32x16_bf16(a, b, c, 0, 0, 0); }
DI f32x16 zero16() { f32x16 z; for (int i = 0; i < 16; ++i) z[i] = 0.f; return z; }
DI bf16x8 mk8(unsigned a, unsigned b, unsigned c, unsigned d) { uint4 u = make_uint4(a, b, c, d); return __builtin_bit_cast(bf16x8, u); }
DI bf16x8 cat8(uint2 lo, uint2 hi) { uint4 u = make_uint4(lo.x, lo.y, hi.x, hi.y); return __builtin_bit_cast(bf16x8, u); }

DI void grid_bar(unsigned* ctrl, unsigned& gen) {
  asm volatile("s_waitcnt vmcnt(0) lgkmcnt(0)" ::: "memory");
  __syncthreads();
  if (threadIdx.x == 0) {
    gen += 1;
    const unsigned g = blockIdx.x & 7, ng = gridDim.x >> 3;
    __builtin_amdgcn_fence(__ATOMIC_RELEASE, "agent");
    asm volatile("s_waitcnt vmcnt(0)" ::: "memory");
    const unsigned old = atomicAdd(ctrl + 16 + 16 * g, 1u);
    if (old == gen * ng - 1) {
      const unsigned o2 = atomicAdd(ctrl, 1u);
      if (o2 == gen * 8 - 1) {
#pragma unroll
        for (int i = 0; i < 8; ++i) __hip_atomic_store(ctrl + 144 + 16 * i, gen, __ATOMIC_RELAXED, __HIP_MEMORY_SCOPE_AGENT);
      }
    }
    while (__hip_atomic_load(ctrl + 144 + 16 * g, __ATOMIC_RELAXED, __HIP_MEMORY_SCOPE_AGENT) < gen) __builtin_amdgcn_s_sleep(1);
    __builtin_amdgcn_fence(__ATOMIC_ACQUIRE, "agent");
    asm volatile("s_waitcnt vmcnt(0)" ::: "memory");
  }
  __syncthreads();
}
DI int next_tile(unsigned* ctr, int* s_tile) {
  __syncthreads();
  if (threadIdx.x == 0) *s_tile = (int)atomicAdd(ctr, 1u);
  __syncthreads();
  return *s_tile;
}
template <class NF, class TF>
DI void run_queues(unsigned* ctr8, int* s_tile, NF nfun, TF tfun) {
  const int x0 = blockIdx.x & 7, ng = gridDim.x >> 3, rank = blockIdx.x >> 3;
  for (int s = 0; s < 8; ++s) {
    const int x = (x0 + s) & 7, n = nfun(x);
    if (n == 0) continue;
    int t = s == 0 ? rank : next_tile(ctr8 + x, s_tile) + ng;
    while (t < n) {
      int nx = 0;
      if (threadIdx.x == 0) nx = (int)atomicAdd(ctr8 + x, 1u) + ng;
      tfun(x, t);
      __syncthreads();
      if (threadIdx.x == 0) *s_tile = nx;
      __syncthreads();
      t = *s_tile;
    }
  }
}
template <class TF>
DI void run_pairs(int npt, TF tfun) {
  const int x = blockIdx.x & 7, rank = blockIdx.x >> 3, hp = gridDim.x >> 4;
  const int pj = rank >> 1, member = rank & 1;
  for (int pt = pj; pt < npt; pt += hp) { __syncthreads(); tfun(x, pt, member); }
  __syncthreads();
}
DI int tok_pos(int m) { return m < MP ? (m & 8191) : (m & 2047); }

template <int EPI>
DI void epilogue_rows(char* lds, int m0, int n0, const EpiArgs& ea) {
  int tid_ = threadIdx.x; asm volatile("" : "+v"(tid_)); const int tid = tid_;
  float* T = (float*)lds;
  float* RS = T + 128 * 132;
  if (EPI != 2) { if (tid < 128) { const float4 s0 = *(const float4*)(ea.ssq_in + (size_t)(m0 + tid) * 8), s1 = *(const float4*)(ea.ssq_in + (size_t)(m0 + tid) * 8 + 4);
      RS[tid] = rsqrtf((((s0.x + s0.y) + (s0.z + s0.w)) + ((s1.x + s1.y) + (s1.z + s1.w))) * (1.f / 1024.f) + EPS); } }
  __syncthreads();
  if (EPI == 1) {
    const int nt = n0 >> 7;
    if (nt < 14) {
      const bool is_a = nt < 5, is_g = nt >= 12, is_q = (nt < 4) || (nt == 5) || (nt == 6);
      const float* gain = nt < 4 ? ea.qn : ea.kn;
      const h16x2* tab = is_a ? ea.tab_ax : ea.tab_seq;
      const float osc = is_q ? 0.125f * LOG2E : ((nt == 10 || nt == 11) ? 0.125f : 1.0f);
#pragma unroll 2
      for (int it = 0; it < 8; ++it) {
        const int idx = it * 256 + tid, row = idx >> 4, c8 = idx & 15, hd = c8 >> 3, i0 = (c8 & 7) * 8;
        const float rs = RS[row];
        float v[8], o[8];
        const float* tp = T + row * 132 + c8 * 8;
#pragma unroll
        for (int j = 0; j < 8; ++j) v[j] = tp[j] * rs;
        if (is_g) {
#pragma unroll
          for (int j = 0; j < 8; ++j) o[j] = v[j] * __builtin_amdgcn_rcpf(1.f + ex2(-v[j] * LOG2E));
        } else {
          float pv[8];
          const float* pp = T + row * 132 + hd * 64 + (i0 ^ 32);
#pragma unroll
          for (int j = 0; j < 8; ++j) pv[j] = pp[j] * rs;
          if (is_a) {
            float ss = 0.f;
#pragma unroll
            for (int j = 0; j < 8; ++j) ss += v[j] * v[j];
            ss += __shfl_xor(ss, 1); ss += __shfl_xor(ss, 2); ss += __shfl_xor(ss, 4);
            const float nr = rsqrtf(ss * (1.f / 64.f) + EPS);
#pragma unroll
            for (int j = 0; j < 8; ++j) { v[j] *= nr * gain[i0 + j]; pv[j] *= nr * gain[(i0 ^ 32) + j]; }
          }
          const int t = tok_pos(m0 + row);
          const h16x2* cs = tab + t * 32 + (i0 & 31);
          const bool lo = i0 < 32;
#pragma unroll
          for (int j = 0; j < 8; ++j) { const h16x2 ch = cs[j]; const float cx = (float)ch.x, cy = (float)ch.y; o[j] = (lo ? (v[j] * cx - pv[j] * cy) : (pv[j] * cy + v[j] * cx)) * osc; }
        }
        uint4 w = make_uint4(pk2(o[0], o[1]), pk2(o[2], o[3]), pk2(o[4], o[5]), pk2(o[6], o[7]));
        *(uint4*)(ea.proj + (size_t)(m0 + row) * PROJ_W + nt * 128 + c8 * 8) = w;
      }
    } else {
      const int vrow0 = (nt - 14) * 128;
#pragma unroll 4
      for (int it = 0; it < 8; ++it) {
        const int idx = it * 256 + tid, n = idx & 127, r0 = (idx >> 7) * 8;
        float o[8];
#pragma unroll
        for (int j = 0; j < 8; ++j) o[j] = T[(r0 + j) * 132 + n] * RS[r0 + j];
        uint4 w = make_uint4(pk2(o[0], o[1]), pk2(o[2], o[3]), pk2(o[4], o[5]), pk2(o[6], o[7]));
        *(uint4*)(ea.vt + (size_t)(vrow0 + n) * M_TOK + m0 + r0) = w;
      }
    }
  } else if (EPI == 2) {
#pragma unroll
    for (int it = 0; it < 8; ++it) {
      const int idx = it * 256 + tid, row = idx >> 4, c8 = idx & 15;
      const float* tp = T + row * 132 + c8 * 8;
      u16* xp = ea.xb + (size_t)(m0 + row) * DM + n0 + c8 * 8;
      const uint4 u = *(const uint4*)xp;
      const float v0 = bflo(u.x) + tp[0], v1 = bfhi(u.x) + tp[1], v2 = bflo(u.y) + tp[2], v3 = bfhi(u.y) + tp[3],
                  v4 = bflo(u.z) + tp[4], v5 = bfhi(u.z) + tp[5], v6 = bflo(u.w) + tp[6], v7 = bfhi(u.w) + tp[7];
      *(uint4*)xp = make_uint4(pk2(v0, v1), pk2(v2, v3), pk2(v4, v5), pk2(v6, v7));
      float ss = v0 * v0 + v1 * v1 + v2 * v2 + v3 * v3 + v4 * v4 + v5 * v5 + v6 * v6 + v7 * v7;
      ss += __shfl_xor(ss, 1); ss += __shfl_xor(ss, 2); ss += __shfl_xor(ss, 4); ss += __shfl_xor(ss, 8);
      if (c8 == 0) ea.ssq_out[(size_t)(m0 + row) * 8 + (n0 >> 7)] = ss;
    }
  } else if (EPI == 3) {
#pragma unroll
    for (int it = 0; it < 8; ++it) {
      const int idx = it * 256 + tid, row = idx >> 4, c8 = idx & 15;
      const float rs = RS[row] * (0.0625f * LOG2E);
      const float* tp = T + row * 132 + c8 * 8;
      uint4 w = make_uint4(pk2(tp[0] * rs, tp[1] * rs), pk2(tp[2] * rs, tp[3] * rs), pk2(tp[4] * rs, tp[5] * rs), pk2(tp[6] * rs, tp[7] * rs));
      *(uint4*)(ea.o16 + (size_t)(m0 + row) * DM + n0 + c8 * 8) = w;
    }
  } else if (EPI == 4) {
    const int nt = n0 >> 7;
#pragma unroll
    for (int it = 0; it < 4; ++it) {
      const int idx = it * 256 + tid, row = idx >> 3, c8 = idx & 7;
      const float rs = RS[row];
      const float* tp = T + row * 132 + c8 * 8;
      float o[8];
#pragma unroll
      for (int j = 0; j < 8; ++j) { const float g = tp[j] * rs, u = tp[64 + j] * rs; o[j] = g * __builtin_amdgcn_rcpf(1.f + ex2(-g * LOG2E)) * u; }
      uint4 w = make_uint4(pk2(o[0], o[1]), pk2(o[2], o[3]), pk2(o[4], o[5]), pk2(o[6], o[7]));
      if (nt < 38) *(uint4*)(ea.o16 + (size_t)(m0 + row) * 2432 + nt * 64 + c8 * 8) = w;
      else *(uint4*)(ea.o16b + (size_t)(m0 + row) * 384 + (nt - 38) * 64 + c8 * 8) = w;
    }
  } else if (EPI == 5) {
    const int nt = n0 >> 7;
    if (nt < 8) {
      for (int it = 0; it < 8; ++it) {
        const int idx = it * 256 + tid, row = idx >> 4, c8 = idx & 15;
        const float rs = RS[row];
        const float* tp = T + row * 132 + c8 * 8;
        uint4 w = make_uint4(pk2(tp[0] * rs, tp[1] * rs), pk2(tp[2] * rs, tp[3] * rs), pk2(tp[4] * rs, tp[5] * rs), pk2(tp[6] * rs, tp[7] * rs));
        *(uint4*)(ea.memk + (size_t)(m0 + row) * DM + n0 + c8 * 8) = w;
      }
    } else {
      const int bm = m0 >> 8, j0 = m0 & 255;
      for (int it = 0; it < 8; ++it) {
        const int idx = it * 256 + tid, n = idx & 127, r0 = (idx >> 7) * 8;
        float o[8];
#pragma unroll
        for (int j = 0; j < 8; ++j) o[j] = T[(r0 + j) * 132 + n] * RS[r0 + j];
        uint4 w = make_uint4(pk2(o[0], o[1]), pk2(o[2], o[3]), pk2(o[4], o[5]), pk2(o[6], o[7]));
        *(uint4*)(ea.memvt + ((size_t)(bm * 1024 + (nt - 8) * 128 + n)) * 256 + j0 + r0) = w;
      }
    }
  }
}


template <int EPI>
DI void gemm_tile(const u16* __restrict__ At, int lda, const u16* __restrict__ Bt, int ldb, int K, int m0, int n0, char* lds, const EpiArgs& ea,
                  const u16* __restrict__ At2, int lda2, int ksplit) {
  int tid_ = threadIdx.x; asm volatile("" : "+v"(tid_)); const int tid = tid_, lane = tid & 63, wid = tid >> 6, r = lane & 31, h = lane >> 5;
  const int wr = wid >> 1, wc = wid & 1;
  f32x16 acc[2][2];
  acc[0][0] = zero16(); acc[0][1] = zero16(); acc[1][0] = zero16(); acc[1][1] = zero16();
  const int srow = tid >> 3, skc = tid & 7;
  const u16* ga = At + (size_t)srow * lda + skc * 8;
  const u16* ga2 = At2 + (size_t)srow * lda2 + skc * 8;
  const int ks = ksplit * 64;
  const u16* gb = Bt + (size_t)srow * ldb + skc * 8;
  const int soff = srow * 144 + skc * 16;
  u32x16 ra0, rb0, ra1, rb1;
#define G_LOAD(RA, RB, KO) { const int ko_ = (KO); const u16* gx_ = ko_ < ks ? ga + ko_ : ga2 + (ko_ - ks); const int ldx_ = ko_ < ks ? lda : lda2; \
    _Pragma("unroll") for (int i = 0; i < 4; ++i) { LD4(RA, i, gx_ + (size_t)(32 * i) * ldx_); LD4(RB, i, gb + (size_t)(32 * i) * ldb + ko_); } }
#define G_STORE(RA, RB, ST) _Pragma("unroll") for (int i = 0; i < 4; ++i) { *(uint4*)(lds + (ST) * 36864 + soff + i * 4608) = GET4(RA, i); *(uint4*)(lds + (ST) * 36864 + 18432 + soff + i * 4608) = GET4(RB, i); }
#define G_COMPUTE(ST) _Pragma("unroll") for (int s = 0; s < 4; ++s) { \
      const char* base = lds + (ST) * 36864; \
      bf16x8 a0 = *(const bf16x8*)(base + aoff + s * 32), a1 = *(const bf16x8*)(base + aoff + 4608 + s * 32); \
      bf16x8 b0 = *(const bf16x8*)(base + boff + s * 32), b1 = *(const bf16x8*)(base + boff + 4608 + s * 32); \
      acc[0][0] = mfma(a0, b0, acc[0][0]); acc[0][1] = mfma(a0, b1, acc[0][1]); \
      acc[1][0] = mfma(a1, b0, acc[1][0]); acc[1][1] = mfma(a1, b1, acc[1][1]); }
#define G_SCHED { __builtin_amdgcn_sched_group_barrier(0x100, 4, 0); \
    __builtin_amdgcn_sched_group_barrier(0x100, 4, 0); __builtin_amdgcn_sched_group_barrier(0x020, 2, 0); __builtin_amdgcn_sched_group_barrier(0x008, 4, 0); __builtin_amdgcn_sched_group_barrier(0x200, 2, 0); \
    __builtin_amdgcn_sched_group_barrier(0x100, 4, 0); __builtin_amdgcn_sched_group_barrier(0x020, 2, 0); __builtin_amdgcn_sched_group_barrier(0x008, 4, 0); __builtin_amdgcn_sched_group_barrier(0x200, 2, 0); \
    __builtin_amdgcn_sched_group_barrier(0x100, 4, 0); __builtin_amdgcn_sched_group_barrier(0x020, 2, 0); __builtin_amdgcn_sched_group_barrier(0x008, 4, 0); __builtin_amdgcn_sched_group_barrier(0x200, 2, 0); \
    __builtin_amdgcn_sched_group_barrier(0x020, 2, 0); __builtin_amdgcn_sched_group_barrier(0x008, 4, 0); __builtin_amdgcn_sched_group_barrier(0x200, 2, 0); }
  const int nk = K >> 6;
  const int aoff = (wr * 64 + r) * 144 + h * 16;
  const int boff = 18432 + (wc * 64 + r) * 144 + h * 16;
  G_LOAD(ra0, rb0, 0)
  G_LOAD(ra1, rb1, 64)
  G_STORE(ra0, rb0, 0)
  __syncthreads();
  for (int kt = 0; kt < nk; kt += 2) {
    { const int ko = (kt + 2 < nk ? kt + 2 : nk - 2) * 64; G_LOAD(ra0, rb0, ko) }
    G_COMPUTE(0)
    G_STORE(ra1, rb1, 1)
    G_SCHED
    __syncthreads();
    { const int ko = (kt + 3 < nk ? kt + 3 : nk - 1) * 64; G_LOAD(ra1, rb1, ko) }
    G_COMPUTE(1)
    G_STORE(ra0, rb0, 0)
    G_SCHED
    __syncthreads();
  }
#undef G_LOAD
#undef G_STORE
#undef G_COMPUTE
#undef G_SCHED
  {
    float* T = (float*)lds;
#pragma unroll
    for (int mt = 0; mt < 2; ++mt)
#pragma unroll
      for (int nt = 0; nt < 2; ++nt)
#pragma unroll
        for (int i = 0; i < 16; ++i) T[(wr * 64 + mt * 32 + crow(i, h)) * 132 + wc * 64 + nt * 32 + r] = acc[mt][nt][i];
  }
  epilogue_rows<EPI>(lds, m0, n0, ea);
}

template <int EPI>
DI void gemm_tile256(const u16* __restrict__ At, int lda, const u16* __restrict__ Bt, int ldb, int K, int m0, int n0, char* lds, const EpiArgs& ea) {
  int tid_ = threadIdx.x; asm volatile("" : "+v"(tid_)); const int tid = tid_, lane = tid & 63, wid = tid >> 6, r = lane & 31, h = lane >> 5;
  const int wr = wid >> 1, wc = wid & 1;
  f32x16 acc[4][2];
#pragma unroll
  for (int i = 0; i < 4; ++i) { acc[i][0] = zero16(); acc[i][1] = zero16(); }
  const int srow = tid >> 3, skc = tid & 7;
  const u16* ga = At + (size_t)srow * lda + skc * 8;
  const u16* gb = Bt + (size_t)srow * ldb + skc * 8;
  const int soff = srow * 144 + skc * 16;
  const int aoff = (wr * 128 + r) * 144 + h * 16;
  const int boff = 36864 + (wc * 64 + r) * 144 + h * 16;
  u32x16 raL, raH, rb;
#define H_LOAD(KO) _Pragma("unroll") for (int i = 0; i < 4; ++i) { LD4(raL, i, ga + (size_t)(32 * i) * lda + (KO)); LD4(raH, i, ga + (size_t)(128 + 32 * i) * lda + (KO)); LD4(rb, i, gb + (size_t)(32 * i) * ldb + (KO)); }
  const int nk = K >> 6;
  H_LOAD(0)
  for (int kt = 0; kt < nk; ++kt) {
    __syncthreads();
#pragma unroll
    for (int i = 0; i < 4; ++i) { *(uint4*)(lds + soff + i * 4608) = GET4(raL, i); *(uint4*)(lds + 18432 + soff + i * 4608) = GET4(raH, i); *(uint4*)(lds + 36864 + soff + i * 4608) = GET4(rb, i); }
    __syncthreads();
    if (kt + 1 < nk) { H_LOAD((kt + 1) * 64) }
#pragma unroll
    for (int s = 0; s < 4; ++s) {
      bf16x8 b0 = *(const bf16x8*)(lds + boff + s * 32), b1 = *(const bf16x8*)(lds + boff + 4608 + s * 32);
#pragma unroll
      for (int mt = 0; mt < 4; ++mt) {
        bf16x8 a = *(const bf16x8*)(lds + aoff + mt * 4608 + s * 32);
        acc[mt][0] = mfma(a, b0, acc[mt][0]); acc[mt][1] = mfma(a, b1, acc[mt][1]);
      }
    }
  }
#undef H_LOAD
#pragma unroll
  for (int p = 0; p < 2; ++p) {
    __syncthreads();
    if (wr == p) {
      float* T = (float*)lds;
#pragma unroll
      for (int mt = 0; mt < 4; ++mt)
#pragma unroll
        for (int nt = 0; nt < 2; ++nt)
#pragma unroll
          for (int i = 0; i < 16; ++i) T[(mt * 32 + crow(i, h)) * 132 + wc * 64 + nt * 32 + r] = acc[mt][nt][i];
    }
    epilogue_rows<EPI>(lds, m0 + p * 128, n0, ea);
  }
}

template <bool WIN, bool NOMAX = false>
DI void attn64_tile(const u16* __restrict__ proj, const u16* __restrict__ vt, u16* __restrict__ mix, int brow0, int T, int q0, int qcol,
                    int kcol, int vtrow, int outcol, float sink2, char* lds) {
  int tid_ = threadIdx.x; asm volatile("" : "+v"(tid_)); const int tid = tid_, lane = tid & 63, wid = tid >> 6, r = lane & 31, h = lane >> 5;
  const int qi = q0 + wid * 32 + r;
  bf16x8 qf[4];
  {
    const u16* qp = proj + (size_t)(brow0 + qi) * PROJ_W + qcol + h * 8;
#pragma unroll
    for (int s = 0; s < 4; ++s) qf[s] = *(const bf16x8*)(qp + s * 16);
  }
  int kt_lo = 0, kt_hi = T >> 6;
  if (WIN) { kt_lo = (q0 - 128) >> 6; if (kt_lo < 0) kt_lo = 0; kt_hi = (q0 + 256) >> 6; if (kt_hi > (T >> 6)) kt_hi = T >> 6; }
  const int srow = tid >> 3, skc = tid & 7;
  const u16* gk = proj + (size_t)(brow0 + srow) * PROJ_W + kcol + skc * 8;
  const u16* gv = vt + (size_t)(vtrow + srow) * M_TOK + brow0 + skc * 8;
  u32x8 rk0, rv0, rk1, rv1;
#define A_LOAD(RK, RV, KT) { const int k0_ = (KT) * 64; _Pragma("unroll") for (int i = 0; i < 2; ++i) { LD4(RK, i, gk + (size_t)(k0_ + 32 * i) * PROJ_W); LD4(RV, i, gv + (size_t)(32 * i) * M_TOK + k0_); } }
#define A_STORE(RK, RV, ST) { _Pragma("unroll") for (int i = 0; i < 2; ++i) { *(uint4*)(lds + (ST) * 17920 + skoff + i * 4608) = GET4(RK, i); \
    *(uint2*)(lds + (ST) * 17920 + svoff + i * 4352) = GETLO(RV, i); *(uint2*)(lds + (ST) * 17920 + svoff + i * 4352 + 8) = GETHI(RV, i); } }
  const int skoff = srow * 144 + skc * 16, svoff = 9216 + srow * 136 + skc * 16;
  const int ntile = kt_hi - kt_lo;
  A_LOAD(rk0, rv0, kt_lo)
  A_LOAD(rk1, rv1, kt_lo + 1)
  A_STORE(rk0, rv0, 0)
  __syncthreads();
  f32x16 O0 = zero16(), O1 = zero16();
  float m = WIN ? sink2 : 0.f, l = 0.f;
  const int koff = r * 144 + h * 16, voff = 9216 + r * 136 + h * 8;
  auto compute = [&](const char* base, int kt) {
    f32x16 s0, s1;
    if (NOMAX) { s0 = zero16(); s1 = zero16(); }
    else { const float nm = -m;
#pragma unroll
      for (int i = 0; i < 16; ++i) { s0[i] = nm; s1[i] = nm; } }
#pragma unroll
    for (int s = 0; s < 4; ++s) {
      bf16x8 k0f = *(const bf16x8*)(base + koff + s * 32), k1f = *(const bf16x8*)(base + koff + 4608 + s * 32);
      s0 = mfma(k0f, qf[s], s0); s1 = mfma(k1f, qf[s], s1);
    }
    if (WIN) {
      const int kb = kt * 64;
#pragma unroll
      for (int i = 0; i < 16; ++i) {
        const int j0 = kb + crow(i, h), d0 = qi - j0, d1 = d0 - 32;
        if (d0 > 128 || d0 < -128) s0[i] = -1e30f;
        if (d1 > 128 || d1 < -128) s1[i] = -1e30f;
      }
    }
    if (!NOMAX) {
    float mx = max3f_after_mfma(s0[0], s1[0], s0[1]);
    mx = max3f(mx, s1[1], s0[2]);
#pragma unroll
    for (int i = 2; i < 15; ++i) mx = max3f(mx, s1[i], s0[i + 1]);
    mx = max3f(mx, s1[15], s1[15]);
    mx = fmaxf(mx, __shfl_xor(mx, 32));
    if (__any(mx > 8.f)) {
      const float dm = mx > 8.f ? mx : 0.f, alpha = ex2(-dm);
      m += dm; l *= alpha;
#pragma unroll
      for (int i = 0; i < 16; ++i) { s0[i] -= dm; s1[i] -= dm; O0[i] *= alpha; O1[i] *= alpha; }
    }
    }
    f32x2_t ps2 = {0.f, 0.f};
#pragma unroll
    for (int i = 0; i < 16; i += 2) {
      s0[i] = ex2(s0[i]); s0[i + 1] = ex2(s0[i + 1]); s1[i] = ex2(s1[i]); s1[i + 1] = ex2(s1[i + 1]);
      ps2 += (f32x2_t){s0[i], s0[i + 1]}; ps2 += (f32x2_t){s1[i], s1[i + 1]};
    }
    l += ps2.x + ps2.y;
    bf16x8 pf[2][2];
    pf[0][0] = mk8(pk2(s0[0], s0[1]), pk2(s0[2], s0[3]), pk2(s0[4], s0[5]), pk2(s0[6], s0[7]));
    pf[0][1] = mk8(pk2(s0[8], s0[9]), pk2(s0[10], s0[11]), pk2(s0[12], s0[13]), pk2(s0[14], s0[15]));
    pf[1][0] = mk8(pk2(s1[0], s1[1]), pk2(s1[2], s1[3]), pk2(s1[4], s1[5]), pk2(s1[6], s1[7]));
    pf[1][1] = mk8(pk2(s1[8], s1[9]), pk2(s1[10], s1[11]), pk2(s1[12], s1[13]), pk2(s1[14], s1[15]));
#pragma unroll
    for (int sub = 0; sub < 2; ++sub)
#pragma unroll
      for (int st = 0; st < 2; ++st) {
        const char* vb = base + voff + (sub * 32 + st * 16) * 2;
        bf16x8 v0 = cat8(*(const uint2*)vb, *(const uint2*)(vb + 16));
        bf16x8 v1 = cat8(*(const uint2*)(vb + 4352), *(const uint2*)(vb + 4352 + 16));
        O0 = mfma(v0, pf[sub][st], O0); O1 = mfma(v1, pf[sub][st], O1);
      }
  };
  for (int i = 0; i < ntile; i += 2) {
    if (i + 2 < ntile) A_LOAD(rk0, rv0, kt_lo + i + 2)
    compute(lds, kt_lo + i);
    A_STORE(rk1, rv1, 1)
    __syncthreads();
    if (i + 3 < ntile) A_LOAD(rk1, rv1, kt_lo + i + 3)
    compute(lds + 17920, kt_lo + i + 1);
    if (i + 2 < ntile) A_STORE(rk0, rv0, 0)
    __syncthreads();
  }
#undef A_LOAD
#undef A_STORE
  float lt = l + __shfl_xor(l, 32);
  if (WIN) lt += ex2(sink2 - m);
  const float inv = 1.f / lt;
  u16* op = mix + (size_t)(brow0 + qi) * DM + outcol + 4 * h;
#pragma unroll
  for (int g = 0; g < 4; ++g) {
    *(uint2*)(op + 8 * g) = make_uint2(pk2(O0[4 * g] * inv, O0[4 * g + 1] * inv), pk2(O0[4 * g + 2] * inv, O0[4 * g + 3] * inv));
    *(uint2*)(op + 32 + 8 * g) = make_uint2(pk2(O1[4 * g] * inv, O1[4 * g + 1] * inv), pk2(O1[4 * g + 2] * inv, O1[4 * g + 3] * inv));
  }
}

DI void xattn_tile(const u16* __restrict__ xq, const u16* __restrict__ memk, const u16* __restrict__ memvt, u16* __restrict__ o, int m0, int hx, char* lds) {
  int tid_ = threadIdx.x; asm volatile("" : "+v"(tid_)); const int tid = tid_, lane = tid & 63, wid = tid >> 6, r = lane & 31, h = lane >> 5;
  const int qg = wid >> 1, dh = wid & 1;
  const int row = m0 + qg * 32 + r;
  const int bm = m0 < MP ? (m0 >> 13) : 4 + ((m0 - MP) >> 11);
  {
    const u16* qp = xq + (size_t)(m0 + (tid >> 5)) * DM + hx * 256 + (tid & 31) * 8;
    char* qd = lds + 35328 + (tid >> 5) * 528 + (tid & 31) * 16;
#pragma unroll
    for (int i = 0; i < 8; ++i) *(uint4*)(qd + i * 8 * 528) = *(const uint4*)(qp + (size_t)(8 * i) * DM);
  }
  const u16* gk = memk + (size_t)(bm * 256 + (tid >> 5)) * DM + hx * 256 + (tid & 31) * 8;
  const u16* gv = memvt + (size_t)(bm * 1024 + hx * 256 + (tid >> 2)) * 256 + (tid & 3) * 8;
  const int skoff = (tid >> 5) * 528 + (tid & 31) * 16, svoff = 16896 + (tid >> 2) * 72 + (tid & 3) * 16;
  u32x16 rk, rv;
#pragma unroll
  for (int i = 0; i < 4; ++i) { LD4(rk, i, gk + (size_t)(8 * i) * DM); LD4(rv, i, gv + (size_t)(64 * i) * 256); }
  f32x16 O[4];
#pragma unroll
  for (int i = 0; i < 4; ++i) O[i] = zero16();
  float m = -1e30f, l = 0.f;
  const int koff = r * 528 + h * 16, qoff = 35328 + (qg * 32 + r) * 528 + h * 16, voff = 16896 + (dh * 128 + r) * 72 + h * 8;
#pragma unroll 1
  for (int kt = 0; kt < 8; ++kt) {
    __syncthreads();
#pragma unroll
    for (int i = 0; i < 4; ++i) {
      *(uint4*)(lds + skoff + i * 8 * 528) = GET4(rk, i);
      *(uint2*)(lds + svoff + i * 64 * 72) = GETLO(rv, i); *(uint2*)(lds + svoff + i * 64 * 72 + 8) = GETHI(rv, i);
    }
    __syncthreads();
    if (kt < 7) {
      const int k0 = (kt + 1) * 32;
#pragma unroll
      for (int i = 0; i < 4; ++i) { LD4(rk, i, gk + (size_t)(k0 + 8 * i) * DM); LD4(rv, i, gv + (size_t)(64 * i) * 256 + k0); }
    }
    f32x16 s0 = zero16();
#pragma unroll
    for (int s = 0; s < 16; ++s) { bf16x8 kf = *(const bf16x8*)(lds + koff + s * 32); bf16x8 qf = *(const bf16x8*)(lds + qoff + s * 32); s0 = mfma(kf, qf, s0); }
    float mx = s0[0];
#pragma unroll
    for (int i = 1; i < 16; ++i) mx = fmaxf(mx, s0[i]);
    mx = fmaxf(mx, __shfl_xor(mx, 32));
    const float mn = fmaxf(m, mx), alpha = ex2(m - mn);
    m = mn;
    float ps = 0.f;
#pragma unroll
    for (int i = 0; i < 16; ++i) { s0[i] = ex2(s0[i] - mn); ps += s0[i]; }
    l = l * alpha + ps;
#pragma unroll
    for (int dt = 0; dt < 4; ++dt)
#pragma unroll
      for (int i = 0; i < 16; ++i) O[dt][i] *= alpha;
    bf16x8 pf[2];
    pf[0] = mk8(pk2(s0[0], s0[1]), pk2(s0[2], s0[3]), pk2(s0[4], s0[5]), pk2(s0[6], s0[7]));
    pf[1] = mk8(pk2(s0[8], s0[9]), pk2(s0[10], s0[11]), pk2(s0[12], s0[13]), pk2(s0[14], s0[15]));
#pragma unroll
    for (int dt = 0; dt < 4; ++dt)
#pragma unroll
      for (int st = 0; st < 2; ++st) {
        const char* vb = lds + voff + dt * 32 * 72 + st * 32;
        bf16x8 vf = cat8(*(const uint2*)vb, *(const uint2*)(vb + 16));
        O[dt] = mfma(vf, pf[st], O[dt]);
      }
  }
  const float inv = 1.f / (l + __shfl_xor(l, 32));
  u16* op = o + (size_t)row * DM + hx * 256 + dh * 128 + 4 * h;
#pragma unroll
  for (int dt = 0; dt < 4; ++dt)
#pragma unroll
    for (int g = 0; g < 4; ++g)
      *(uint2*)(op + dt * 32 + 8 * g) = make_uint2(pk2(O[dt][4 * g] * inv, O[dt][4 * g + 1] * inv), pk2(O[dt][4 * g + 2] * inv, O[dt][4 * g + 3] * inv));
}

DI void ret_kv_tile(const u16* __restrict__ proj, const u16* __restrict__ vt, u16* __restrict__ st, int cgi, int hc, float lgf2, float lgb2, char* lds) {
  int tid_ = threadIdx.x; asm volatile("" : "+v"(tid_)); const int tid = tid_;
  float* KF = (float*)lds;
  float* VT = KF + 128 * 64;
  float* WF = VT + 64 * 132;
  float* WB = WF + 128;
  const int row0 = cgi * 128;
  for (int i = 0; i < 4; ++i) {
    const int c = tid + 256 * i, rr = c >> 3, kc = c & 7;
    const uint4 u = *(const uint4*)(proj + (size_t)(row0 + rr) * PROJ_W + C_KC + hc * 64 + kc * 8);
    float* d = KF + rr * 64 + kc * 8;
    d[0] = bflo(u.x); d[1] = bfhi(u.x); d[2] = bflo(u.y); d[3] = bfhi(u.y); d[4] = bflo(u.z); d[5] = bfhi(u.z); d[6] = bflo(u.w); d[7] = bfhi(u.w);
    const int e = c >> 4, cc = (c & 15) * 8;
    const uint4 w = *(const uint4*)(vt + (size_t)(256 + hc * 64 + e) * M_TOK + row0 + cc);
    float* dv = VT + e * 132 + cc;
    dv[0] = bflo(w.x); dv[1] = bfhi(w.x); dv[2] = bflo(w.y); dv[3] = bfhi(w.y); dv[4] = bflo(w.z); dv[5] = bfhi(w.z); dv[6] = bflo(w.w); dv[7] = bfhi(w.w);
  }
  if (tid < 128) { WF[tid] = ex2(lgf2 * (float)(127 - tid)); WB[tid] = ex2(lgb2 * (float)tid); }
  __syncthreads();
  const int e = tid >> 2, d0 = (tid & 3) * 16;
  float af[16], ab[16];
#pragma unroll
  for (int j = 0; j < 16; ++j) { af[j] = 0.f; ab[j] = 0.f; }
  for (int c = 0; c < 128; ++c) {
    const float vv = VT[e * 132 + c], vf = vv * WF[c], vb = vv * WB[c];
    const float* kp = KF + c * 64 + d0;
#pragma unroll
    for (int j = 0; j < 16; ++j) { const float kk = kp[j]; af[j] += vf * kk; ab[j] += vb * kk; }
  }
  u16* pf = st + ((size_t)(cgi * 4 + hc)) * 4096 + e * 64 + d0;
  u16* pb = pf + (size_t)384 * 4 * 4096;
  *(uint4*)pf = make_uint4(pk2(af[0], af[1]), pk2(af[2], af[3]), pk2(af[4], af[5]), pk2(af[6], af[7]));
  *(uint4*)(pf + 8) = make_uint4(pk2(af[8], af[9]), pk2(af[10], af[11]), pk2(af[12], af[13]), pk2(af[14], af[15]));
  *(uint4*)pb = make_uint4(pk2(ab[0], ab[1]), pk2(ab[2], ab[3]), pk2(ab[4], ab[5]), pk2(ab[6], ab[7]));
  *(uint4*)(pb + 8) = make_uint4(pk2(ab[8], ab[9]), pk2(ab[10], ab[11]), pk2(ab[12], ab[13]), pk2(ab[14], ab[15]));
}

DI void ret_out_tile(const u16* __restrict__ proj, const u16* __restrict__ vt, const u16* __restrict__ st, u16* __restrict__ mix, const float* __restrict__ gn,
                     int cgi, int hc, float lgf2, float lgb2, char* lds) {
  int tid_ = threadIdx.x; asm volatile("" : "+v"(tid_)); const int tid = tid_, lane = tid & 63, wid = tid >> 6, r = lane & 31, h = lane >> 5;
  const int row0 = cgi * 128;
  for (int i = 0; i < 4; ++i) {
    const int c = tid + 256 * i;
    { const int rr = c >> 3, kc = c & 7; *(uint4*)(lds + rr * 144 + kc * 16) = *(const uint4*)(proj + (size_t)(row0 + rr) * PROJ_W + C_KC + hc * 64 + kc * 8); }
    { const int e = c >> 4, cc = c & 15; const uint4 w = *(const uint4*)(vt + (size_t)(256 + hc * 64 + e) * M_TOK + row0 + cc * 8);
      char* d = lds + 18432 + e * 264 + cc * 16; *(uint2*)d = make_uint2(w.x, w.y); *(uint2*)(d + 8) = make_uint2(w.z, w.w); }
  }
  for (int i = 0; i < 2; ++i) {
    const int c = tid + 256 * i, e = c >> 3, kc = c & 7;
    const u16* sp = st + ((size_t)(cgi * 4 + hc)) * 4096 + e * 64 + kc * 8;
    *(uint4*)(lds + 35328 + e * 144 + kc * 16) = *(const uint4*)sp;
    *(uint4*)(lds + 44544 + e * 144 + kc * 16) = *(const uint4*)(sp + (size_t)384 * 4 * 4096);
  }
  const int a = wid * 32 + r;
  bf16x8 qf[4];
  {
    const u16* qp = proj + (size_t)(row0 + a) * PROJ_W + C_QC + hc * 64 + h * 8;
#pragma unroll
    for (int s = 0; s < 4; ++s) qf[s] = *(const bf16x8*)(qp + s * 16);
  }
  __syncthreads();
  f32x16 O0, O1;
  {
    f32x16 t10 = zero16(), t11 = zero16(), t20 = zero16(), t21 = zero16();
    const int so = r * 144 + h * 16;
#pragma unroll
    for (int s = 0; s < 4; ++s) {
      bf16x8 f0 = *(const bf16x8*)(lds + 35328 + so + s * 32), f1 = *(const bf16x8*)(lds + 35328 + 4608 + so + s * 32);
      bf16x8 b0 = *(const bf16x8*)(lds + 44544 + so + s * 32), b1 = *(const bf16x8*)(lds + 44544 + 4608 + so + s * 32);
      t10 = mfma(f0, qf[s], t10); t11 = mfma(f1, qf[s], t11); t20 = mfma(b0, qf[s], t20); t21 = mfma(b1, qf[s], t21);
    }
    const float df = ex2(lgf2 * (float)(a + 1)), db = ex2(lgb2 * (float)(128 - a));
#pragma unroll
    for (int i = 0; i < 16; ++i) { O0[i] = df * t10[i] + db * t20[i]; O1[i] = df * t11[i] + db * t21[i]; }
  }
  const int koff = r * 144 + h * 16, voff = 18432 + r * 264 + h * 8;
#pragma unroll 1
  for (int kt = 0; kt < 4; ++kt) {
    f32x16 s0 = zero16();
#pragma unroll
    for (int s = 0; s < 4; ++s) { bf16x8 kf = *(const bf16x8*)(lds + koff + kt * 4608 + s * 32); s0 = mfma(kf, qf[s], s0); }
#pragma unroll
    for (int i = 0; i < 16; ++i) {
      const int c = kt * 32 + crow(i, h), df = a - c;
      const float w = df >= 0 ? ex2(lgf2 * (float)df) : ex2(lgb2 * (float)(-df));
      s0[i] *= w;
    }
    bf16x8 p0 = mk8(pk2(s0[0], s0[1]), pk2(s0[2], s0[3]), pk2(s0[4], s0[5]), pk2(s0[6], s0[7]));
    bf16x8 p1 = mk8(pk2(s0[8], s0[9]), pk2(s0[10], s0[11]), pk2(s0[12], s0[13]), pk2(s0[14], s0[15]));
    const char* vb = lds + voff + kt * 64;
    bf16x8 v00 = cat8(*(const uint2*)vb, *(const uint2*)(vb + 16)), v01 = cat8(*(const uint2*)(vb + 32), *(const uint2*)(vb + 48));
    bf16x8 v10 = cat8(*(const uint2*)(vb + 8448), *(const uint2*)(vb + 8448 + 16)), v11 = cat8(*(const uint2*)(vb + 8448 + 32), *(const uint2*)(vb + 8448 + 48));
    O0 = mfma(v00, p0, O0); O0 = mfma(v01, p1, O0); O1 = mfma(v10, p0, O1); O1 = mfma(v11, p1, O1);
  }
  float sm = 0.f;
#pragma unroll
  for (int i = 0; i < 16; ++i) sm += O0[i] + O1[i];
  sm += __shfl_xor(sm, 32);
  const float mean = sm * (1.f / 64.f);
  float sv = 0.f;
#pragma unroll
  for (int i = 0; i < 16; ++i) { O0[i] -= mean; O1[i] -= mean; sv += O0[i] * O0[i] + O1[i] * O1[i]; }
  sv += __shfl_xor(sv, 32);
  const float rstd = rsqrtf(sv * (1.f / 64.f) + EPS);
  const u16* gp = proj + (size_t)(row0 + a) * PROJ_W + C_GC + hc * 64 + 4 * h;
  const float* gnp = gn + hc * 64 + 4 * h;
  u16* op = mix + (size_t)(row0 + a) * DM + 768 + hc * 64 + 4 * h;
#pragma unroll
  for (int g = 0; g < 4; ++g) {
    {
      const uint2 sg = *(const uint2*)(gp + 8 * g); const float4 gg = *(const float4*)(gnp + 8 * g);
      const float o0 = O0[4 * g] * rstd * gg.x * bflo(sg.x), o1 = O0[4 * g + 1] * rstd * gg.y * bfhi(sg.x), o2 = O0[4 * g + 2] * rstd * gg.z * bflo(sg.y), o3 = O0[4 * g + 3] * rstd * gg.w * bfhi(sg.y);
      *(uint2*)(op + 8 * g) = make_uint2(pk2(o0, o1), pk2(o2, o3));
    }
    {
      const uint2 sg = *(const uint2*)(gp + 32 + 8 * g); const float4 gg = *(const float4*)(gnp + 32 + 8 * g);
      const float o0 = O1[4 * g] * rstd * gg.x * bflo(sg.x), o1 = O1[4 * g + 1] * rstd * gg.y * bfhi(sg.x), o2 = O1[4 * g + 2] * rstd * gg.z * bflo(sg.y), o3 = O1[4 * g + 3] * rstd * gg.w * bfhi(sg.y);
      *(uint2*)(op + 32 + 8 * g) = make_uint2(pk2(o0, o1), pk2(o2, o3));
    }
  }
}

DI void norm_mix_tile(u16* __restrict__ mix, const float* __restrict__ ga, const float* __restrict__ gb, int row0) {
  int tid_ = threadIdx.x; asm volatile("" : "+v"(tid_)); const int tid = tid_, lane = tid & 63, wid = tid >> 6;
  const int l5 = lane & 31;
  float gA[8], gB[8];
#pragma unroll
  for (int j = 0; j < 8; ++j) { gA[j] = ga[lane * 8 + j]; gB[j] = gb[l5 * 8 + j]; }
  for (int rb = 0; rb < 8; rb += 4) {
    uint4 ua[4], ub[4];
#pragma unroll
    for (int k = 0; k < 4; ++k) { const u16* p = mix + (size_t)(row0 + wid * 8 + rb + k) * DM; ua[k] = *(const uint4*)(p + lane * 8); ub[k] = *(const uint4*)(p + 512 + l5 * 8); }
#pragma unroll
    for (int k = 0; k < 4; ++k) {
      u16* p = mix + (size_t)(row0 + wid * 8 + rb + k) * DM;
      {
        const uint4 u = ua[k];
        float v[8] = {bflo(u.x), bfhi(u.x), bflo(u.y), bfhi(u.y), bflo(u.z), bfhi(u.z), bflo(u.w), bfhi(u.w)};
        float ss = 0.f;
#pragma unroll
        for (int j = 0; j < 8; ++j) ss += v[j] * v[j];
        for (int o = 32; o; o >>= 1) ss += __shfl_xor(ss, o);
        const float rs = rsqrtf(ss * (1.f / 512.f) + EPS);
        *(uint4*)(p + lane * 8) = make_uint4(pk2(v[0] * rs * gA[0], v[1] * rs * gA[1]), pk2(v[2] * rs * gA[2], v[3] * rs * gA[3]), pk2(v[4] * rs * gA[4], v[5] * rs * gA[5]), pk2(v[6] * rs * gA[6], v[7] * rs * gA[7]));
      }
      {
        const uint4 u = ub[k];
        float v[8] = {bflo(u.x), bfhi(u.x), bflo(u.y), bfhi(u.y), bflo(u.z), bfhi(u.z), bflo(u.w), bfhi(u.w)};
        float ss = 0.f;
#pragma unroll
        for (int j = 0; j < 8; ++j) ss += v[j] * v[j];
        for (int o = 16; o; o >>= 1) ss += __shfl_xor(ss, o);
        const float rs = rsqrtf(ss * (1.f / 256.f) + EPS);
        if (lane < 32)
          *(uint4*)(p + 512 + l5 * 8) = make_uint4(pk2(v[0] * rs * gB[0], v[1] * rs * gB[1]), pk2(v[2] * rs * gB[2], v[3] * rs * gB[3]), pk2(v[4] * rs * gB[4], v[5] * rs * gB[5]), pk2(v[6] * rs * gB[6], v[7] * rs * gB[7]));
      }
    }
  }
}

DI void conv_tile(const float* __restrict__ src, int K, int N, const float* __restrict__ g, u16* __restrict__ dst, int k0, int n0, int dstrow0, char* lds) {
  int tid_ = threadIdx.x; asm volatile("" : "+v"(tid_)); const int tid = tid_;
  float* S = (float*)lds;
  const int nn = tid & 63, kq = tid >> 6;
#pragma unroll
  for (int i = 0; i < 16; ++i) {
    const int kk = kq + 4 * i;
    float v = src[(size_t)(k0 + kk) * N + n0 + nn];
    if (g) v *= g[k0 + kk];
    S[nn * 65 + kk] = v;
  }
  __syncthreads();
  const int n2 = tid >> 2, kk2 = (tid & 3) * 16;
  const float* sp = S + n2 * 65 + kk2;
  u16* dp = dst + (size_t)(dstrow0 + n2) * K + k0 + kk2;
  *(uint4*)dp = make_uint4(pk2(sp[0], sp[1]), pk2(sp[2], sp[3]), pk2(sp[4], sp[5]), pk2(sp[6], sp[7]));
  *(uint4*)(dp + 8) = make_uint4(pk2(sp[8], sp[9]), pk2(sp[10], sp[11]), pk2(sp[12], sp[13]), pk2(sp[14], sp[15]));
  __syncthreads();
}

DI void conv_job(const Params& p, u16* W, int l, int q, char* lds) {
  u16* Wl = W + (size_t)l * W_LAYER;
  const float* src; const float* g = nullptr; u16* dst; int K = 1024, N, kt, nb, drow;
  if (q < 576) { N = 2304; src = p.w_in + (size_t)l * 1024 * 2304; g = p.g_mix + l * 1024; dst = Wl + W_IN; kt = q / 36; nb = q % 36;
    int db_;
    if (nb < 10) db_ = nb; else if (nb < 12) db_ = nb + 18; else if (nb < 18) db_ = nb - 2; else if (nb < 20) db_ = nb + 12; else if (nb < 28) db_ = nb - 4; else if (nb < 32) db_ = nb + 4; else db_ = nb - 8;
    drow = db_ * 64; }
  else if ((q -= 576) < 256) { N = 1024; src = p.w_out + (size_t)l * 1024 * 1024; dst = Wl + W_OUT; kt = q / 16; nb = q % 16; drow = nb * 64; }
  else if ((q -= 256) < 256) { N = 1024; src = p.w_xq + (size_t)l * 1024 * 1024; g = p.g_cross + l * 1024; dst = Wl + W_XQ; kt = q / 16; nb = q % 16; drow = nb * 64; }
  else if ((q -= 256) < 256) { N = 1024; src = p.w_xk + (size_t)l * 1024 * 1024; g = p.g_mem + l * 1024; dst = Wl + W_XKV; kt = q / 16; nb = q % 16; drow = nb * 64; }
  else if ((q -= 256) < 256) { N = 1024; src = p.w_xv + (size_t)l * 1024 * 1024; g = p.g_mem + l * 1024; dst = Wl + W_XKV; kt = q / 16; nb = q % 16; drow = 1024 + nb * 64; }
  else if ((q -= 256) < 256) { N = 1024; src = p.w_xo + (size_t)l * 1024 * 1024; dst = Wl + W_XO; kt = q / 16; nb = q % 16; drow = nb * 64; }
  else if ((q -= 256) < 704) { N = DFF; src = p.w_gate + (size_t)l * 1024 * DFF; g = p.g_ffn + l * 1024; dst = Wl + W_GU; kt = q / 44; nb = q % 44; drow = nb * 128; }
  else if ((q -= 704) < 704) { N = DFF; src = p.w_up + (size_t)l * 1024 * DFF; g = p.g_ffn + l * 1024; dst = Wl + W_GU; kt = q / 44; nb = q % 44; drow = nb * 128 + 64; }
  else { q -= 704; K = DFF; N = 1024; src = p.w_down + (size_t)l * DFF * 1024; dst = Wl + W_DN; kt = q / 16; nb = q % 16; drow = nb * 64; }
  conv_tile(src, K, N, g, dst, kt * 64, nb * 64, drow, lds);
}

__global__ void __launch_bounds__(NT, 2) mega(Params p) {
  __shared__ __attribute__((aligned(16))) char lds[LDS_BYTES];
  __shared__ int s_tile;
  cg::grid_group grid = cg::this_grid();
  unsigned tgt = 0;
  const int tid = threadIdx.x, lane = tid & 63, wid = tid >> 6;
  const int gw = blockIdx.x * 4 + wid, nw = gridDim.x * 4;
  unsigned* ctrl = (unsigned*)(p.ws + OFF_CTRL);
  unsigned* qctr = ctrl + 512;
  int qn = 0;
  float* ssqA = (float*)(p.ws + OFF_SSQ2);
  float* ssqB = ssqA + (size_t)M_TOK * 8; float* ssqC = ssqB + (size_t)M_TOK * 8; float* ssq_mem = ssqC + (size_t)M_TOK * 8;
  h16x2* tab_seq = (h16x2*)(p.ws + OFF_TAB);
  h16x2* tab_ax = tab_seq + 8192 * 32;
  u16* memb = (u16*)(p.ws + OFF_MEMB);
  u16* memk = (u16*)(p.ws + OFF_MEMK);
  u16* memvt = (u16*)(p.ws + OFF_MEMVT);
  u16* st = (u16*)(p.ws + OFF_ST);
  u16* W = (u16*)(p.ws + OFF_W);
  u16* rega = (u16*)(p.ws + OFF_REGA);
  u16* x16 = (u16*)(p.ws + OFF_MIXB);
  u16* mixb = (u16*)p.out;
  u16* proj = rega;
  u16* vt = rega + (size_t)M_TOK * PROJ_W;
  u16* xqb = rega + (size_t)M_TOK * DM;
  u16* act1 = rega;
  u16* act2 = (u16*)p.out + (size_t)M_TOK * DM;

  {
    const int gt = blockIdx.x * NT + tid, ngt = gridDim.x * NT;
    for (int i = gt; i < 8192 * 32; i += ngt) {
      const int t = i >> 5, f = i & 31;
      {
        double inv = 1.0; for (int k = 0; k < f; ++k) inv *= 0.7498942093324559;
        double rev = (double)t * inv * 0.15915494309189535; rev -= rint(rev);
        const float rf = (float)rev; tab_seq[i] = (h16x2){(_Float16)__builtin_amdgcn_cosf(rf), (_Float16)__builtin_amdgcn_sinf(rf)};
      }
      {
        const int pos = f < 16 ? (t >> 6) : (t & 63); const int ff = f & 15;
        double inv = 1.0; for (int k = 0; k < ff; ++k) inv *= 0.5623413251903491;
        double rev = (double)pos * inv * 0.15915494309189535; rev -= rint(rev);
        const float rf = (float)rev; tab_ax[i] = (h16x2){(_Float16)__builtin_amdgcn_cosf(rf), (_Float16)__builtin_amdgcn_sinf(rf)};
      }
    }
    for (int rr = gw; rr < M_TOK + NMEM; rr += nw) {
      const bool isx = rr < M_TOK;
      const float* src; u16* db; float* sq;
      if (isx) { src = rr < MP ? p.x_prompt + (size_t)rr * DM : p.x_sample + (size_t)(rr - MP) * DM; db = x16 + (size_t)rr * DM; sq = ssqA + (size_t)rr * 8; }
      else { const int mr = rr - M_TOK; src = mr < 1024 ? p.mem_prompt + (size_t)mr * DM : p.mem_sample + (size_t)(mr - 1024) * DM; db = memb + (size_t)mr * DM; sq = ssq_mem + (size_t)mr * 8; }
      float s = 0.f;
      for (int c = lane * 4; c < DM; c += 256) {
        const float4 v = *(const float4*)(src + c);
        s += v.x * v.x + v.y * v.y + v.z * v.z + v.w * v.w;
        *(uint2*)(db + c) = make_uint2(pk2(v.x, v.y), pk2(v.z, v.w));
      }
      for (int o = 32; o; o >>= 1) s += __shfl_xor(s, o);
      if (lane < 8) sq[lane] = lane == 0 ? s : 0.f;
    }
    for (int t = blockIdx.x; t < 3968; t += gridDim.x) conv_job(p, W, 0, t, lds);
  }
  if (p.ws == nullptr) grid.sync();
  grid_bar(ctrl, tgt);

  for (int l = 0; l < 4; ++l) {
    const u16* Wl = W + (size_t)l * W_LAYER;
    {
      EpiArgs ea{}; ea.ssq_in = ssqA; ea.proj = proj; ea.vt = vt; ea.tab_seq = tab_seq; ea.tab_ax = tab_ax;
      ea.qn = p.a_q_norm + l * 64; ea.kn = p.a_k_norm + l * 64;
      EpiArgs eb{}; eb.ssq_in = ssq_mem; eb.memk = memk; eb.memvt = memvt;
      unsigned* qc = qctr + 8 * (qn++);
      (void)qc;
      run_pairs(216, [&](int x, int pt, int mb) {
        const int sg = pt / 72, rem = pt % 72, nt = (rem >> 3) * 2 + mb, mt = x * 24 + sg * 8 + (rem & 7);
        gemm_tile256<1>(x16 + (size_t)mt * 256 * DM, DM, Wl + W_IN + (size_t)nt * 128 * DM, DM, DM, mt * 256, nt * 128, lds, ea); });
      unsigned* qc2 = qctr + 8 * (qn++);
      run_queues(qc2, &s_tile, [](int x) { return x < 6 ? 32 : 0; }, [&](int x, int q) {
        const int nt = q >> 1, mt = x * 2 + (q & 1);
        gemm_tile256<5>(memb + (size_t)mt * 256 * DM, DM, Wl + W_XKV + (size_t)nt * 128 * DM, DM, DM, mt * 256, nt * 128, lds, eb); });
    }
    grid_bar(ctrl, tgt);
    {
      unsigned* qc = qctr + 8 * (qn++);
      float gq = 0.f, gk = 0.f;
      for (int i = 0; i < 64; ++i) { gq = fmaxf(gq, fabsf(p.a_q_norm[l * 64 + i])); gk = fmaxf(gk, fabsf(p.a_k_norm[l * 64 + i])); }
      const bool nomax = 64.f * gq * gk * (0.125f * LOG2E) < 60.f;
      const int nq2 = l < 3 ? 768 + 496 : 768;
      run_queues(qc, &s_tile, [=](int) { return nq2; }, [&](int x, int qq) {
        int q = qq;
        if (nq2 > 768) {
          if (qq < 992) { if (qq & 1) { conv_job(p, W, l + 1, x * 496 + (qq >> 1), lds); return; } q = qq >> 1; }
          else q = qq - 496;
        }
        if (q < 256) { const int b = x >> 1, kvh = x & 1, qb = q >> 2, g = q & 3;
          if (nomax) attn64_tile<false, true>(proj, vt, mixb, b * 8192, 8192, qb * 128, C_QA + (kvh * 4 + g) * 64, C_KA + kvh * 64, kvh * 64, (kvh * 4 + g) * 64, 0.f, lds);
          else attn64_tile<false>(proj, vt, mixb, b * 8192, 8192, qb * 128, C_QA + (kvh * 4 + g) * 64, C_KA + kvh * 64, kvh * 64, (kvh * 4 + g) * 64, 0.f, lds); }
        else if (q < 384) { const int u = q - 256, pr = 2 * x + (u >> 6), b = pr >> 1, kvh = pr & 1, qb = (u >> 2) & 15, g = u & 3;
          if (nomax) attn64_tile<false, true>(proj, vt, mixb, MP + b * 2048, 2048, qb * 128, C_QA + (kvh * 4 + g) * 64, C_KA + kvh * 64, kvh * 64, (kvh * 4 + g) * 64, 0.f, lds);
          else attn64_tile<false>(proj, vt, mixb, MP + b * 2048, 2048, qb * 128, C_QA + (kvh * 4 + g) * 64, C_KA + kvh * 64, kvh * 64, (kvh * 4 + g) * 64, 0.f, lds); }
        else if (q < 576) { const int u = q - 384, hb = u & 3, cgi = x * 48 + (u >> 2); int brow0, T, q0;
          if (cgi < 256) { brow0 = (cgi >> 6) * 8192; T = 8192; q0 = (cgi & 63) * 128; } else { const int c2 = cgi - 256; brow0 = MP + (c2 >> 4) * 2048; T = 2048; q0 = (c2 & 15) * 128; }
          const int kvh = hb >> 1;
          attn64_tile<true>(proj, vt, mixb, brow0, T, q0, C_QB + hb * 64, C_KB + kvh * 64, 128 + kvh * 64, 512 + hb * 64, p.b_sink[l * 4 + hb] * LOG2E, lds); }
        else { const int u = q - 576, hc = u & 3, cgi = x * 48 + (u >> 2);
          ret_kv_tile(proj, vt, st, cgi, hc, -expf(p.c_decay_fwd[l * 4 + hc]) * LOG2E, -expf(p.c_decay_bwd[l * 4 + hc]) * LOG2E, lds); } });
    }
    grid_bar(ctrl, tgt);
    {
      const int gt = blockIdx.x * NT + tid, ngt = gridDim.x * NT;
      for (int it = gt; it < 49152; it += ngt) {
        const int el = it & 511, hc = (it >> 9) & 3, dir = (it >> 11) & 1, seq = it >> 12;
        const int nc = seq < 4 ? 64 : 16, cg0 = seq < 4 ? seq * 64 : 256 + (seq - 4) * 16;
        const float dec = ex2(-expf((dir ? p.c_decay_bwd : p.c_decay_fwd)[l * 4 + hc]) * LOG2E * 128.f);
        float S[8];
#pragma unroll
        for (int j = 0; j < 8; ++j) S[j] = 0.f;
        u16* base = st + ((size_t)dir * 384 * 4 + hc) * 4096 + el * 8;
        for (int i = 0; i < nc; i += 4) {
          u32x16 tm;
#pragma unroll
          for (int k = 0; k < 4; ++k) { const int n = dir ? nc - 1 - (i + k) : (i + k); LD4(tm, k, base + (size_t)(cg0 + n) * 4 * 4096); }
#pragma unroll
          for (int k = 0; k < 4; ++k) {
            const int n = dir ? nc - 1 - (i + k) : (i + k);
            *(uint4*)(base + (size_t)(cg0 + n) * 4 * 4096) = make_uint4(pk2(S[0], S[1]), pk2(S[2], S[3]), pk2(S[4], S[5]), pk2(S[6], S[7]));
            const uint4 tk = GET4(tm, k);
            S[0] = dec * S[0] + bflo(tk.x); S[1] = dec * S[1] + bfhi(tk.x); S[2] = dec * S[2] + bflo(tk.y); S[3] = dec * S[3] + bfhi(tk.y);
            S[4] = dec * S[4] + bflo(tk.z); S[5] = dec * S[5] + bfhi(tk.z); S[6] = dec * S[6] + bflo(tk.w); S[7] = dec * S[7] + bfhi(tk.w);
          }
        }
      }
    }
    grid_bar(ctrl, tgt);
    {
      unsigned* qc = qctr + 8 * (qn++);
      run_queues(qc, &s_tile, [](int) { return 384; }, [&](int x, int q) {
        if (q < 192) { const int hc = q & 3, cgi = x * 48 + (q >> 2);
          ret_out_tile(proj, vt, st, mixb, p.c_gn + l * 256, cgi, hc, -expf(p.c_decay_fwd[l * 4 + hc]) * LOG2E, -expf(p.c_decay_bwd[l * 4 + hc]) * LOG2E, lds); }
        else norm_mix_tile(mixb, p.a_out_norm + l * 512, p.b_out_norm + l * 256, (x * 192 + q - 192) * 32); });
    }
    grid_bar(ctrl, tgt);
    {
      EpiArgs ea{}; ea.xb = x16; ea.ssq_out = ssqB;
      unsigned* qc = qctr + 8 * (qn++);
      (void)qc;
      run_pairs(96, [&](int x, int pt, int mb) {
        const int nt = ((pt >> 3) & 3) * 2 + mb, mt = x * 24 + (pt >> 5) * 8 + (pt & 7);
        gemm_tile256<2>(mixb + (size_t)mt * 256 * DM, DM, Wl + W_OUT + (size_t)nt * 128 * DM, DM, DM, mt * 256, nt * 128, lds, ea); });
    }
    grid_bar(ctrl, tgt);
    {
      EpiArgs ea{}; ea.ssq_in = ssqB; ea.o16 = xqb;
      unsigned* qc = qctr + 8 * (qn++);
      (void)qc;
      run_pairs(96, [&](int x, int pt, int mb) {
        const int nt = ((pt >> 3) & 3) * 2 + mb, mt = x * 24 + (pt >> 5) * 8 + (pt & 7);
        gemm_tile256<3>(x16 + (size_t)mt * 256 * DM, DM, Wl + W_XQ + (size_t)nt * 128 * DM, DM, DM, mt * 256, nt * 128, lds, ea); });
    }
    grid_bar(ctrl, tgt);
    {
      unsigned* qc = qctr + 8 * (qn++);
      run_queues(qc, &s_tile, [](int) { return 384; }, [&](int x, int q) { xattn_tile(xqb, memk, memvt, mixb, (x * 96 + (q >> 2)) * 64, q & 3, lds); });
    }
    grid_bar(ctrl, tgt);
    {
      EpiArgs ea{}; ea.xb = x16; ea.ssq_out = ssqC;
      unsigned* qc = qctr + 8 * (qn++);
      (void)qc;
      run_pairs(96, [&](int x, int pt, int mb) {
        const int nt = ((pt >> 3) & 3) * 2 + mb, mt = x * 24 + (pt >> 5) * 8 + (pt & 7);
        gemm_tile256<2>(mixb + (size_t)mt * 256 * DM, DM, Wl + W_XO + (size_t)nt * 128 * DM, DM, DM, mt * 256, nt * 128, lds, ea); });
    }
    grid_bar(ctrl, tgt);
    {
      EpiArgs ea{}; ea.ssq_in = ssqC; ea.o16 = act1; ea.o16b = act2;
      unsigned* qc = qctr + 8 * (qn++);
      (void)qc;
      run_pairs(528, [&](int x, int pt, int mb) {
        const int sg = pt / 176, rem = pt % 176, nt = (rem >> 3) * 2 + mb, mt = x * 24 + sg * 8 + (rem & 7), m0 = mt * 256;
        gemm_tile256<4>(x16 + (size_t)m0 * DM, DM, Wl + W_GU + (size_t)nt * 128 * DM, DM, DM, m0, nt * 128, lds, ea); });
    }
    grid_bar(ctrl, tgt);
    {
      EpiArgs ea{}; ea.xb = x16; ea.ssq_out = ssqA;
      unsigned* qc = qctr + 8 * (qn++);
      (void)qc;
      run_pairs(192, [&](int x, int pt, int mb) {
        const int nt = ((pt >> 3) & 3) * 2 + mb, mt = x * 48 + (pt >> 5) * 8 + (pt & 7), m0 = mt * 128;
        gemm_tile<2>(act1 + (size_t)m0 * 2432, 2432, Wl + W_DN + (size_t)nt * 128 * DFF, DFF, DFF, m0, nt * 128, lds, ea, act2 + (size_t)m0 * 384, 384, 38); });
    }
    grid_bar(ctrl, tgt);
  }
  {
    for (int rr = gw; rr < M_TOK; rr += nw) {
      const float4 q0 = *(const float4*)(ssqA + (size_t)rr * 8), q1 = *(const float4*)(ssqA + (size_t)rr * 8 + 4);
      const float rs = rsqrtf((((q0.x + q0.y) + (q0.z + q0.w)) + ((q1.x + q1.y) + (q1.z + q1.w))) * (1.f / DM) + EPS);
      for (int c = lane * 4; c < DM; c += 256) {
        const uint2 u = *(const uint2*)(x16 + (size_t)rr * DM + c);
        float4 v = make_float4(bflo(u.x), bfhi(u.x), bflo(u.y), bfhi(u.y));
        const float4 g = *(const float4*)(p.g_final + c);
        v.x *= rs * g.x; v.y *= rs * g.y; v.z *= rs * g.z; v.w *= rs * g.w;
        *(float4*)(p.out + (size_t)rr * DM + c) = v;
      }
    }
  }
}

extern "C" void kernel_launch(void* const* d_in, const int* in_sizes, int n_in, void* d_out, int out_size, void* d_ws, size_t ws_size, hipStream_t stream) {
  static int grid_blocks = 0;
  if (!grid_blocks) {
    int dev = 0, cus = 0, per_cu = 0;
    (void)hipGetDevice(&dev);
    (void)hipDeviceGetAttribute(&cus, hipDeviceAttributeMultiprocessorCount, dev);
    (void)hipOccupancyMaxActiveBlocksPerMultiprocessor(&per_cu, mega, NT, 0);
    if (per_cu > 2) per_cu = 2;
    grid_blocks = cus * per_cu;
  }
  if (ws_size < WS_NEED) { fprintf(stderr, "workspace too small: %zu < %zu\n", ws_size, (size_t)WS_NEED); return; }
  Params p{};
  const float** pp = (const float**)&p;
  for (int i = 0; i < 26; ++i) pp[i] = (const float*)d_in[i];
  p.out = (float*)d_out; p.ws = (char*)d_ws;
  (void)hipMemsetAsync(d_ws, 0, 4096, stream);
  void* args[] = {&p};
  hipError_t e = hipLaunchCooperativeKernel((void*)mega, dim3(grid_blocks), dim3(NT), args, 0, stream);
  if (e != hipSuccess) fprintf(stderr, "coop launch failed: %s (grid %d)\n", hipGetErrorString(e), grid_blocks);
}
```
